# Optimizing an MI355X kernel written in HIP

```python
import math
import jax
import jax.numpy as jnp
from jax import lax
import numpy as np


D_MODEL = 1024
BATCH = 8
SEQ = 4096
DEPTH = 4

N_MIXERS = 4
HEAD_DIM = 64
N_HEADS = D_MODEL // HEAD_DIM
ROT_DIM = HEAD_DIM // 4
ROPE_THETA = 500000.0
Q_BLOCK = 128
D_FF = 2816
ALPHA = (2 * DEPTH) ** 0.25
BETA = (8 * DEPTH) ** -0.25
N_ADA = 9
LN_EPS = 1e-5
RMS_EPS = 1e-6

A_KV_RANK = 128
A_IDX_HEADS = 8
A_IDX_DIM = 32
A_TOPK_MAX = 256
A_IN = D_MODEL + A_KV_RANK + A_IDX_HEADS * A_IDX_DIM + A_IDX_DIM + A_IDX_HEADS
B_IN = 3 * D_MODEL + N_HEADS
C_KV_HEADS = 2
C_GROUP = N_HEADS // C_KV_HEADS
C_WINDOW = 128
C_IN = D_MODEL + 2 * C_KV_HEADS * HEAD_DIM
D_HEADS = N_HEADS // 2
D_QK_DIM = HEAD_DIM
D_V_DIM = 2 * HEAD_DIM
D_IN = 2 * D_HEADS * 2 * D_QK_DIM + D_HEADS * D_V_DIM

kernel_name = 'hybrid_interleaved_dsa_fox_swa_diff_macaron'


def layer_norm(x, g, b):
    xf = x.astype(jnp.float32)
    mu = jnp.mean(xf, axis=-1, keepdims=True)
    var = jnp.mean(jnp.square(xf - mu), axis=-1, keepdims=True)
    return ((xf - mu) * lax.rsqrt(var + LN_EPS) * g + b).astype(x.dtype)


def rms_norm(x, g):
    xf = x.astype(jnp.float32)
    return (xf * lax.rsqrt(jnp.mean(xf * xf, axis=-1, keepdims=True) + RMS_EPS) * g).astype(x.dtype)


def rope_tables(seq, rot_dim):
    inv = ROPE_THETA ** (-jnp.arange(0, rot_dim, 2, dtype=jnp.float32) / rot_dim)
    ang = jnp.arange(seq, dtype=jnp.float32)[:, None] * inv[None, :]
    return jnp.cos(ang), jnp.sin(ang)


def partial_rope(x, cos, sin):
    half = cos.shape[-1]
    x1, x2, rest = x[..., :half], x[..., half:2 * half], x[..., 2 * half:]
    c = cos[:, None, :].astype(x.dtype)
    s = sin[:, None, :].astype(x.dtype)
    return jnp.concatenate([x1 * c - x2 * s, x2 * c + x1 * s, rest], axis=-1)


def to_blocks(t):
    b, s = t.shape[:2]
    return jnp.moveaxis(t.reshape(b, s // Q_BLOCK, Q_BLOCK, *t.shape[2:]), 1, 0)


def from_blocks(t):
    nb, b, q = t.shape[:3]
    return jnp.moveaxis(t, 0, 1).reshape(b, nb * q, *t.shape[3:])


def swiglu(h, w_in, w_out):
    g, u = jnp.split(h @ w_in, 2, axis=-1)
    return (jax.nn.silu(g) * u) @ w_out


def mixer_dsa(h, w_in, kv_norm, w_kv_up, w_out, cos, sin, cos_i, sin_i):
    b, s, _ = h.shape
    k_sel = min(A_TOPK_MAX, s // 4)
    splits = [D_MODEL, D_MODEL + A_KV_RANK, D_MODEL + A_KV_RANK + A_IDX_HEADS * A_IDX_DIM,
              D_MODEL + A_KV_RANK + A_IDX_HEADS * A_IDX_DIM + A_IDX_DIM]
    q, c_kv, q_idx, k_idx, w_idx = jnp.split(h @ w_in, splits, axis=-1)
    q = partial_rope(q.reshape(b, s, N_HEADS, HEAD_DIM), cos, sin)
    kv = rms_norm(c_kv, kv_norm) @ w_kv_up
    k = partial_rope(kv[:, :, None, :HEAD_DIM], cos, sin)[:, :, 0]
    v = kv[..., HEAD_DIM:]
    q_idx = partial_rope(q_idx.reshape(b, s, A_IDX_HEADS, A_IDX_DIM), cos_i, sin_i)
    k_idx = partial_rope(k_idx[:, :, None, :], cos_i, sin_i)[:, :, 0]
    w_idx = w_idx * (A_IDX_HEADS ** -0.5 * A_IDX_DIM ** -0.5)
    key_pos = jnp.arange(s)

    def block(args):
        qx, qix, wix, qpos = args
        rel = jax.nn.relu(jnp.einsum('bqhd,bkd->bqhk', qix, k_idx))
        score = jnp.einsum('bqh,bqhk->bqk', wix, rel).astype(jnp.float32)
        score = jnp.where((key_pos[None, :] <= qpos[:, None])[None], score, -jnp.inf)
        _, sel = lax.top_k(score, k_sel)
        valid = sel <= qpos[None, :, None]
        kg = jax.vmap(lambda kb, ib: kb[ib])(k, sel)
        vg = jax.vmap(lambda vb, ib: vb[ib])(v, sel)
        logits = jnp.einsum('bqhd,bqkd->bhqk', qx, kg).astype(jnp.float32) * HEAD_DIM ** -0.5
        logits = jnp.where(valid[:, None], logits, -jnp.inf)
        p = jax.nn.softmax(logits, axis=-1).astype(vg.dtype)
        return jnp.einsum('bhqk,bqkd->bqhd', p, vg)

    out = lax.map(block, (to_blocks(q), to_blocks(q_idx), to_blocks(w_idx), key_pos.reshape(-1, Q_BLOCK)))
    return from_blocks(out).reshape(b, s, D_MODEL) @ w_out


def mixer_fox(h, w_in, f_bias, w_out):
    b, s, _ = h.shape
    q, k, v, f = jnp.split(h @ w_in, [D_MODEL, 2 * D_MODEL, 3 * D_MODEL], axis=-1)
    q = q.reshape(b, s, N_HEADS, HEAD_DIM)
    k = k.reshape(b, s, N_HEADS, HEAD_DIM)
    v = v.reshape(b, s, N_HEADS, HEAD_DIM)
    log_f = jax.nn.log_sigmoid((f + f_bias).astype(jnp.float32))
    cum = jnp.cumsum(log_f, axis=1)
    cum_k = jnp.moveaxis(cum, 1, 2)
    key_pos = jnp.arange(s)

    def block(args):
        qx, cq, qpos = args
        logits = jnp.einsum('bqhd,bkhd->bhqk', qx, k).astype(jnp.float32) * HEAD_DIM ** -0.5
        logits = logits + jnp.moveaxis(cq, 1, 2)[..., None] - cum_k[:, :, None, :]
        logits = jnp.where(key_pos[None, :] <= qpos[:, None], logits, -jnp.inf)
        p = jax.nn.softmax(logits, axis=-1).astype(v.dtype)
        return jnp.einsum('bhqk,bkhd->bqhd', p, v)

    out = lax.map(block, (to_blocks(q), to_blocks(cum), key_pos.reshape(-1, Q_BLOCK)))
    return from_blocks(out).reshape(b, s, D_MODEL) @ w_out


def mixer_swa(h, w_in, sinks, w_out, cos, sin):
    b, s, _ = h.shape
    nb = s // Q_BLOCK
    q, k, v = jnp.split(h @ w_in, [D_MODEL, D_MODEL + C_KV_HEADS * HEAD_DIM], axis=-1)
    q = partial_rope(q.reshape(b, s, N_HEADS, HEAD_DIM), cos, sin)
    k = partial_rope(k.reshape(b, s, C_KV_HEADS, HEAD_DIM), cos, sin)
    v = v.reshape(b, s, C_KV_HEADS, HEAD_DIM)

    def band(t):
        tb = t.reshape(b, nb, Q_BLOCK, C_KV_HEADS, HEAD_DIM)
        prev = jnp.pad(tb, ((0, 0), (1, 0), (0, 0), (0, 0), (0, 0)))[:, :-1]
        return jnp.moveaxis(jnp.concatenate([prev, tb], axis=2), 1, 0)

    qb = jnp.moveaxis(q.reshape(b, nb, Q_BLOCK, C_KV_HEADS, C_GROUP, HEAD_DIM), 1, 0)
    qi = jnp.arange(Q_BLOCK)[:, None] + Q_BLOCK
    ki = jnp.arange(2 * Q_BLOCK)[None, :]
    in_window = (ki <= qi) & (qi - ki < C_WINDOW)
    sink = sinks.reshape(C_KV_HEADS, C_GROUP).astype(jnp.float32)

    def block(args):
        qx, kx, vx, n = args
        logits = jnp.einsum('bqgrd,bkgd->bgrqk', qx, kx).astype(jnp.float32) * HEAD_DIM ** -0.5
        ok = in_window & ((ki >= Q_BLOCK) | (n > 0))
        logits = jnp.where(ok, logits, -jnp.inf)
        sink_col = jnp.broadcast_to(sink[None, :, :, None, None], logits.shape[:-1] + (1,))
        p = jax.nn.softmax(jnp.concatenate([logits, sink_col], axis=-1), axis=-1)[..., :-1]
        return jnp.einsum('bgrqk,bkgd->bqgrd', p.astype(vx.dtype), vx)

    out = lax.map(block, (qb, band(k), band(v), jnp.arange(nb)))
    return jnp.moveaxis(out, 0, 1).reshape(b, s, D_MODEL) @ w_out


def mixer_diff(h, w_in, lam, subln_g, w_out, cos, sin, lambda_init):
    b, s, _ = h.shape
    qk_w = D_HEADS * 2 * D_QK_DIM
    q, k, v = jnp.split(h @ w_in, [qk_w, 2 * qk_w], axis=-1)
    q = partial_rope(q.reshape(b, s, 2 * D_HEADS, D_QK_DIM), cos, sin).reshape(b, s, D_HEADS, 2, D_QK_DIM)
    k = partial_rope(k.reshape(b, s, 2 * D_HEADS, D_QK_DIM), cos, sin).reshape(b, s, D_HEADS, 2, D_QK_DIM)
    v = v.reshape(b, s, D_HEADS, D_V_DIM)
    lam_f = lam.astype(jnp.float32)
    lam_val = (jnp.exp(jnp.sum(lam_f[0] * lam_f[1])) - jnp.exp(jnp.sum(lam_f[2] * lam_f[3])) + lambda_init)
    key_pos = jnp.arange(s)

    def block(args):
        qx, qpos = args
        logits = jnp.einsum('bqhcd,bkhcd->bhcqk', qx, k).astype(jnp.float32) * D_QK_DIM ** -0.5
        logits = jnp.where(key_pos[None, :] <= qpos[:, None], logits, -jnp.inf)
        p = jax.nn.softmax(logits, axis=-1)
        a = p[:, :, 0] - lam_val * p[:, :, 1]
        return jnp.einsum('bhqk,bkhd->bqhd', a.astype(v.dtype), v)

    out = from_blocks(lax.map(block, (to_blocks(q), key_pos.reshape(-1, Q_BLOCK))))
    out = rms_norm(out, subln_g) * (1.0 - lambda_init)
    return out.reshape(b, s, D_HEADS * D_V_DIM) @ w_out


def modulated_post_norm(x, mod, j, fn, res_w, g, b):
    shift, scale, gate = mod[:, 3 * j], mod[:, 3 * j + 1], mod[:, 3 * j + 2]
    y = fn(x * (1.0 + scale) + shift)
    return layer_norm(ALPHA * x + res_w * (1.0 + gate) * y, g, b)


def setup_inputs(seed: int = 0) -> dict:
    key = jax.random.key(seed)
    ks = iter(jax.random.split(key, 32))

    def nrm(shape, scale):
        return jax.random.normal(next(ks), shape, jnp.float32) * scale

    n_of = [len(range(m, DEPTH, N_MIXERS)) for m in range(N_MIXERS)]
    na, nf, nw, nd = n_of
    d = D_MODEL
    return {
        'x': nrm((BATCH, SEQ, d), 1.0),
        'c': nrm((BATCH, d), 1.0),
        'ln_g': 1.0 + nrm((DEPTH, 3, d), 0.05),
        'ln_b': nrm((DEPTH, 3, d), 0.02),
        'w_ada': nrm((DEPTH, d, N_ADA * d), 0.2 * d ** -0.5),
        'b_ada': nrm((DEPTH, N_ADA * d), 0.02),
        'w_ffn_in': nrm((DEPTH, 2, d, 2 * D_FF), d ** -0.5),
        'w_ffn_out': nrm((DEPTH, 2, D_FF, d), BETA * D_FF ** -0.5),
        'dsa_w_in': nrm((na, d, A_IN), d ** -0.5),
        'dsa_kv_norm': 1.0 + nrm((na, A_KV_RANK), 0.05),
        'dsa_w_kv_up': nrm((na, A_KV_RANK, 2 * HEAD_DIM), A_KV_RANK ** -0.5),
        'dsa_w_out': nrm((na, d, d), BETA * d ** -0.5),
        'fox_w_in': nrm((nf, d, B_IN), d ** -0.5),
        'fox_f_bias': jax.random.uniform(next(ks), (nf, N_HEADS), jnp.float32, 1.0, 5.0),
        'fox_w_out': nrm((nf, d, d), BETA * d ** -0.5),
        'swa_w_in': nrm((nw, d, C_IN), d ** -0.5),
        'swa_sinks': nrm((nw, N_HEADS), 0.5),
        'swa_w_out': nrm((nw, d, d), BETA * d ** -0.5),
        'diff_w_in': nrm((nd, d, D_IN), d ** -0.5),
        'diff_lambda': nrm((nd, 4, D_QK_DIM), 0.1),
        'diff_subln': 1.0 + nrm((nd, D_V_DIM), 0.05),
        'diff_w_out': nrm((nd, D_HEADS * D_V_DIM, d), BETA * (D_HEADS * D_V_DIM) ** -0.5),
    }


def reference(x, c, ln_g, ln_b, w_ada, b_ada, w_ffn_in, w_ffn_out,
              dsa_w_in, dsa_kv_norm, dsa_w_kv_up, dsa_w_out,
              fox_w_in, fox_f_bias, fox_w_out,
              swa_w_in, swa_sinks, swa_w_out,
              diff_w_in, diff_lambda, diff_subln, diff_w_out):
    b, s, d = x.shape
    cos, sin = rope_tables(s, ROT_DIM)
    cos_i, sin_i = rope_tables(s, A_IDX_DIM // 4)
    cond = jax.nn.silu(c)
    for i in range(DEPTH):
        m, r = i % N_MIXERS, i // N_MIXERS
        mod = (cond @ w_ada[i] + b_ada[i]).reshape(b, N_ADA, 1, d)
        x = modulated_post_norm(x, mod, 0, lambda h: swiglu(h, w_ffn_in[i, 0], w_ffn_out[i, 0]),
                                0.5, ln_g[i, 0], ln_b[i, 0])
        if m == 0:
            mix = lambda h: mixer_dsa(h, dsa_w_in[r], dsa_kv_norm[r], dsa_w_kv_up[r], dsa_w_out[r],
                                      cos, sin, cos_i, sin_i)
        elif m == 1:
            mix = lambda h: mixer_fox(h, fox_w_in[r], fox_f_bias[r], fox_w_out[r])
        elif m == 2:
            mix = lambda h: mixer_swa(h, swa_w_in[r], swa_sinks[r], swa_w_out[r], cos, sin)
        else:
            lambda_init = 0.8 - 0.6 * math.exp(-0.3 * i)
            mix = lambda h: mixer_diff(h, diff_w_in[r], diff_lambda[r], diff_subln[r], diff_w_out[r],
                                       cos, sin, lambda_init)
        x = modulated_post_norm(x, mod, 1, mix, 1.0, ln_g[i, 1], ln_b[i, 1])
        x = modulated_post_norm(x, mod, 2, lambda h: swiglu(h, w_ffn_in[i, 1], w_ffn_out[i, 1]),
                                0.5, ln_g[i, 2], ln_b[i, 2])
    return x
```

```cpp
#include <hip/hip_runtime.h>
#include <hip/hip_cooperative_groups.h>
#include <cstdio>
#include <cstdint>
namespace cg = cooperative_groups;
namespace pg8 {
#define PG8_LAS __attribute__((address_space(3)))
typedef unsigned short bf16_t;
typedef short bf16x8 __attribute__((ext_vector_type(8)));
typedef float f32x4 __attribute__((ext_vector_type(4)));
typedef unsigned u32x4 __attribute__((ext_vector_type(4)));
constexpr int BM = 256, BK = 64, HALF = 128, HTB = HALF * BK * 2  , STAGE_BYTES = 8 * HTB, NXCD = 8, WGM = 8;

__host__ __device__ __forceinline__ int lds_byte(int r, int c) { const int st = (r >> 4) * 2 + (c >> 5), rr = r & 15, cc = c & 31, ob = rr * 64 + cc * 2; return st * 1024 + (ob ^ (((ob >> 9) & 1) << 5)); }
__host__ __device__ __forceinline__ void stage_rc(int b, int& R, int& C) { const int st = b / 1024, sb = b % 1024, swz = sb ^ (((sb >> 9) & 1) << 5); R = (st >> 1) * 16 + swz / 64; C = (st & 1) * 32 + (swz % 64) / 2; }
__host__ __device__ __forceinline__ int perm32(int rho) { const int n = rho >> 4, i = rho & 15; return 8 * (i >> 2) + 4 * n + (i & 3); }

struct Unit { int pm, pn; };
struct Gemm { const bf16_t* A; const bf16_t* Bt; int M, N, K; };

struct StaticOrder {
    int nM, nN, nwg, G, c;
    __host__ __device__ void init(int M, int N, int G_, int c_) { nM = M / BM; nN = N / BM; nwg = nM * nN; G = G_; c = c_; }
    __host__ __device__ bool next(int i, Unit& u) const {
        const long L = (long)i * G + c; if (L >= nwg) return false;
        int wgid = (int)L; { const int q = nwg / NXCD, r = nwg % NXCD, xcd = wgid % NXCD, off = wgid / NXCD; wgid = (xcd < r ? xcd * (q + 1) : r * (q + 1) + (xcd - r) * q) + off; }
        const int nig = WGM * nN, gid = wgid / nig, fm = gid * WGM, gsz = (nM - fm) < WGM ? (nM - fm) : WGM;
        u.pm = fm + ((wgid % nig) % gsz); u.pn = (wgid % nig) / gsz; return true;
    }
    __device__ __forceinline__ void a_ready(const Unit&) const {}
    __device__ __forceinline__ void done(const Unit&) const {}
};

__device__ __forceinline__ unsigned cvt_pk_bf16(float lo, float hi) { unsigned r; asm volatile("v_cvt_pk_bf16_f32 %0, %1, %2" : "=v"(r) : "v"(lo), "v"(hi)); return r; }
typedef float f32x2 __attribute__((ext_vector_type(2)));
template <class Epi, class Sched, bool ALIGN_EPI = false, bool SP2 = false>
__device__ __forceinline__ void gemm_phase(PG8_LAS unsigned char* lds, const Gemm g, const Sched& S, const Epi& E) {
    int tid_ = threadIdx.x; asm volatile("" : "+v"(tid_));
    const int tid = tid_, wid = __builtin_amdgcn_readfirstlane(tid >> 6), lane = tid & 63, wr = wid >> 2, wc = wid & 3, fr = lane & 15, fq = lane >> 4;
    const int K = g.K, nt = K / BK;
    unsigned voffA[2], voffB[2];
#pragma unroll
    for (int i = 0; i < 2; ++i) { int R, C; stage_rc(tid * 16 + i * 8192, R, C); const int Rb = Epi::PERM ? ((R & ~31) + perm32(R & 31)) : R;
        voffA[i] = (unsigned)(R * K + C) * 2u; voffB[i] = (unsigned)(Rb * K + C) * 2u; }
    const size_t kstep = (size_t)(BK * 2);
    const size_t hstep = (size_t)HALF * K * 2;
    const size_t tstep = 2 * hstep;
    const unsigned ldsw = (unsigned)wid * 1024u;
    const int aoff = lds_byte(wr * 64 + fr, fq * 8), boff = lds_byte(wc * 32 + fr, fq * 8);
#define PG8_SA(b, h) (((b) * 2 + (h)) * HTB)
#define PG8_SB(b, h) ((4 + (b) * 2 + (h)) * HTB)
#define PG8_STAGE(bufoff, gbase, voff) do { _Pragma("unroll") for (int _i = 0; _i < 2; ++_i) \
        __builtin_amdgcn_global_load_lds((const unsigned*)((const char*)(gbase) + (voff)[_i]), (PG8_LAS unsigned*)(lds + (bufoff) + ldsw + _i * 8192), 16, 0, 0); } while (0)
#define PG8_LDA(dst, b, h) do { _Pragma("unroll") for (int m = 0; m < 4; ++m) _Pragma("unroll") for (int k = 0; k < 2; ++k) dst[m][k] = *(const PG8_LAS bf16x8*)(lds + PG8_SA(b, h) + aoff + m * 2048 + k * 1024); } while (0)
#define PG8_LDB(dst, b, h) do { _Pragma("unroll") for (int n = 0; n < 2; ++n) _Pragma("unroll") for (int k = 0; k < 2; ++k) dst[n][k] = *(const PG8_LAS bf16x8*)(lds + PG8_SB(b, h) + boff + n * 2048 + k * 1024); } while (0)
#define PG8_MMA(ai, bj, At, Bt) do { __builtin_amdgcn_s_setprio(1); _Pragma("unroll") for (int m = 0; m < 4; ++m) _Pragma("unroll") for (int n = 0; n < 2; ++n) _Pragma("unroll") for (int k = 0; k < 2; ++k) \
        acc[ai][bj][m][n] = __builtin_amdgcn_mfma_f32_16x16x32_bf16(Bt[n][k], At[m][k], acc[ai][bj][m][n], 0, 0, 0); __builtin_amdgcn_s_setprio(0); } while (0)
#define PG8_WAIT_V(n) asm volatile("s_waitcnt vmcnt(" #n ")" ::: "memory")
#define PG8_WAIT_L(n) asm volatile("s_waitcnt lgkmcnt(" #n ")" ::: "memory")
#define PG8_BAR __builtin_amdgcn_s_barrier()
#define PG8_SCHED __builtin_amdgcn_sched_barrier(0)
    Unit cur, nxt; int ui = 0;
    if (!S.next(0, cur)) return;
    f32x4 acc[2][2][4][2];
#pragma unroll
    for (int a = 0; a < 2; ++a)
#pragma unroll
        for (int b = 0; b < 2; ++b)
#pragma unroll
            for (int m = 0; m < 4; ++m)
#pragma unroll
                for (int n = 0; n < 2; ++n) acc[a][b][m][n] = (f32x4){0.f, 0.f, 0.f, 0.f};
    bf16x8 At[4][2], B0[2][2], B1[2][2];
    const char* cA = (const char*)g.A + (size_t)cur.pm * tstep; const char* cB = (const char*)g.Bt + (size_t)cur.pn * tstep;
    S.a_ready(cur);
    if constexpr (SP2) {
        PG8_STAGE(PG8_SB(0, 0), cB, voffB); PG8_STAGE(PG8_SB(0, 1), cB + hstep, voffB); PG8_STAGE(PG8_SA(0, 0), cA, voffA); PG8_STAGE(PG8_SA(0, 1), cA + hstep, voffA);
        if (wr == 1) PG8_BAR;
        PG8_WAIT_V(2); PG8_BAR;
        PG8_STAGE(PG8_SB(1, 0), cB + kstep, voffB); PG8_STAGE(PG8_SA(1, 0), cA + kstep, voffA); PG8_STAGE(PG8_SB(1, 1), cB + hstep + kstep, voffB);
        PG8_WAIT_V(6); PG8_BAR;
    } else {
        PG8_STAGE(PG8_SB(0, 0), cB, voffB); PG8_STAGE(PG8_SA(0, 0), cA, voffA); PG8_STAGE(PG8_SB(0, 1), cB + hstep, voffB); PG8_STAGE(PG8_SA(0, 1), cA + hstep, voffA);
        if (wr == 1) PG8_BAR;
        PG8_WAIT_V(4); PG8_BAR;
        PG8_STAGE(PG8_SB(1, 0), cB + kstep, voffB); PG8_STAGE(PG8_SA(1, 0), cA + kstep, voffA); PG8_STAGE(PG8_SB(1, 1), cB + hstep + kstep, voffB);
        PG8_WAIT_V(6); PG8_BAR;
    }
    for (;;) {
        const bool has_next = S.next(ui + 1, nxt);
        const char* nA = has_next ? (const char*)g.A + (size_t)nxt.pm * tstep : cA; const char* nB = has_next ? (const char*)g.Bt + (size_t)nxt.pn * tstep : cB;
        for (int t = 0; t < nt; t += 2) {
            const bool last = (t == nt - 2);
            const char* a1 = cA + (size_t)(t + 1) * kstep;
            const char* a2 = last ? nA : cA + (size_t)(t + 2) * kstep; const char* b2 = last ? nB : cB + (size_t)(t + 2) * kstep;
            const char* a3 = a2 + kstep; const char* b3 = b2 + kstep;
            if (last && has_next) S.a_ready(nxt);
            if constexpr (SP2) {
            PG8_LDB(B0, 0, 0); PG8_LDB(B1, 0, 1); PG8_SCHED; PG8_LDA(At, 0, 0); PG8_STAGE(PG8_SA(1, 1), a1 + hstep, voffA);
            PG8_WAIT_V(8); PG8_WAIT_L(0); PG8_BAR; PG8_MMA(0, 0, At, B0); PG8_MMA(0, 1, At, B1); PG8_BAR; PG8_SCHED;
            PG8_LDA(At, 0, 1); PG8_STAGE(PG8_SB(0, 0), b2, voffB); PG8_STAGE(PG8_SB(0, 1), b2 + hstep, voffB); PG8_STAGE(PG8_SA(0, 0), a2, voffA);
            PG8_WAIT_V(8); PG8_WAIT_L(0); PG8_BAR; PG8_MMA(1, 0, At, B0); PG8_MMA(1, 1, At, B1); PG8_BAR; PG8_SCHED;
            PG8_LDB(B0, 1, 0); PG8_LDB(B1, 1, 1); PG8_SCHED; PG8_LDA(At, 1, 0); PG8_STAGE(PG8_SA(0, 1), a2 + hstep, voffA);
            PG8_WAIT_V(8); PG8_WAIT_L(0); PG8_BAR; PG8_MMA(0, 0, At, B0); PG8_MMA(0, 1, At, B1); PG8_BAR; PG8_SCHED;
            PG8_LDA(At, 1, 1); PG8_STAGE(PG8_SB(1, 0), b3, voffB); PG8_STAGE(PG8_SB(1, 1), b3 + hstep, voffB); PG8_STAGE(PG8_SA(1, 0), a3, voffA);
            PG8_WAIT_V(8); PG8_WAIT_L(0); PG8_BAR; PG8_MMA(1, 0, At, B0); PG8_MMA(1, 1, At, B1); PG8_BAR; PG8_SCHED;
            } else {
            PG8_LDB(B0, 0, 0); PG8_SCHED; PG8_LDA(At, 0, 0); PG8_STAGE(PG8_SA(1, 1), a1 + hstep, voffA);
            PG8_WAIT_L(8); PG8_BAR; PG8_WAIT_L(0); PG8_MMA(0, 0, At, B0); PG8_BAR; PG8_SCHED;
            PG8_LDB(B1, 0, 1); PG8_STAGE(PG8_SB(0, 0), b2, voffB);
            PG8_BAR; PG8_WAIT_L(0); PG8_MMA(0, 1, At, B1); PG8_BAR;
            PG8_LDA(At, 0, 1); PG8_STAGE(PG8_SA(0, 0), a2, voffA);
            PG8_BAR; PG8_WAIT_L(0); PG8_MMA(1, 0, At, B0); PG8_BAR; PG8_SCHED;
            PG8_STAGE(PG8_SB(0, 1), b2 + hstep, voffB);
            PG8_WAIT_V(6); PG8_BAR; PG8_MMA(1, 1, At, B1); PG8_BAR;
            PG8_LDB(B0, 1, 0); PG8_SCHED; PG8_LDA(At, 1, 0); PG8_STAGE(PG8_SA(0, 1), a2 + hstep, voffA);
            PG8_WAIT_L(8); PG8_BAR; PG8_WAIT_L(0); PG8_MMA(0, 0, At, B0); PG8_BAR; PG8_SCHED;
            PG8_LDB(B1, 1, 1); PG8_STAGE(PG8_SB(1, 0), b3, voffB);
            PG8_BAR; PG8_WAIT_L(0); PG8_MMA(0, 1, At, B1); PG8_BAR;
            PG8_LDA(At, 1, 1); PG8_STAGE(PG8_SA(1, 0), a3, voffA);
            PG8_BAR; PG8_WAIT_L(0); PG8_MMA(1, 0, At, B0); PG8_BAR; PG8_SCHED;
            PG8_STAGE(PG8_SB(1, 1), b3 + hstep, voffB);
            PG8_WAIT_V(6); PG8_BAR; PG8_MMA(1, 1, At, B1); PG8_BAR;
            }
        }
        if constexpr (ALIGN_EPI) { if (wr == 0) PG8_BAR; }
        if constexpr (!Epi::AFTER_DRAIN) { E(acc, cur, wr, wc, fr, fq); S.done(cur); }
        if (!has_next) break;
#pragma unroll
        for (int a = 0; a < 2; ++a)
#pragma unroll
            for (int b = 0; b < 2; ++b)
#pragma unroll
                for (int m = 0; m < 4; ++m)
#pragma unroll
                    for (int n = 0; n < 2; ++n) acc[a][b][m][n] = (f32x4){0.f, 0.f, 0.f, 0.f};
        cur = nxt; cA = nA; cB = nB; ++ui;
        if constexpr (ALIGN_EPI) { if (wr == 1) PG8_BAR; }
    }
    PG8_WAIT_V(0);
    if constexpr (!ALIGN_EPI) { if (wr == 0) PG8_BAR; }
    PG8_BAR;
    if constexpr (Epi::AFTER_DRAIN) { E.fused(acc, cur, wr, wc, fr, fq, lds, wid, lane); S.done(cur); }
#undef PG8_SA
#undef PG8_SB
#undef PG8_STAGE
#undef PG8_LDA
#undef PG8_LDB
#undef PG8_MMA
#undef PG8_WAIT_V
#undef PG8_WAIT_L
#undef PG8_BAR
#undef PG8_SCHED
}
}
#ifndef RPT_ATT
#define RPT_ATT 0
#endif
#ifndef RPT_DSAX
#define RPT_DSAX 0
#endif
#ifndef RPT_INPROJ
#define RPT_INPROJ 0
#endif
#ifndef RPT_FFNUP
#define RPT_FFNUP 0
#endif
#ifndef RPT_P0
#define RPT_P0 0
#endif
#ifndef RPT_FFNDN
#define RPT_FFNDN 0
#endif
#ifndef RPT_LN
#define RPT_LN 0
#endif
#ifndef RPT_SYNC
#define RPT_SYNC 0
#endif
#ifndef FFNUP_ALIGN
#define FFNUP_ALIGN true
#endif
#ifndef EPIRES_ALIGN
#define EPIRES_ALIGN true
#endif
#define LAS __attribute__((address_space(3)))
typedef unsigned short bf16;
typedef short bf16x8 __attribute__((ext_vector_type(8)));
typedef float f32x4 __attribute__((ext_vector_type(4)));
typedef float f32x16 __attribute__((ext_vector_type(16)));
typedef unsigned u32x4 __attribute__((ext_vector_type(4)));
typedef unsigned u32x2 __attribute__((ext_vector_type(2)));
typedef _Float16 f16;
typedef _Float16 f16x4 __attribute__((ext_vector_type(4)));
constexpr int M = 32768, SEQ = 4096, DM = 1024, FF = 2816, NBATCH = 8, NLAYER = 4;
constexpr int NTHREADS = 512, NWAVES = 8;
constexpr float ALPHA = 1.6817928305074290f;
constexpr float LOG2E = 1.4426950408889634f;
constexpr float C2 = 0.125f * 1.4426950408889634f;
constexpr float LN_EPS = 1e-5f;
constexpr float NEGBIG = -1e30f;
constexpr int MODW = 9 * DM;

constexpr size_t MiB = 1u << 20;
constexpr size_t WS_MOD = 1 * MiB;
constexpr size_t WS_ROPE = 3 * MiB;
constexpr size_t WS_FLOG = 4 * MiB;
constexpr size_t WS_CUMT = 6 * MiB;
constexpr size_t WS_KD = 8 * MiB, WS_VD = 12 * MiB;
constexpr size_t WS_BM = 16 * MiB;
constexpr size_t WS_W = 32 * MiB;
constexpr size_t WS_H = 200 * MiB;
constexpr size_t WS_ATT = 264 * MiB;
constexpr size_t WS_BIG = 328 * MiB;
constexpr size_t WS_SC = 424 * MiB;
constexpr size_t WS_PARK = 560 * MiB;
constexpr size_t WS_END = 696 * MiB;
constexpr size_t W_FI = 0, W_FI_SZ = (size_t)5632 * 1024 * 2;
constexpr size_t W_FO = 8 * W_FI_SZ, W_FO_SZ = (size_t)1024 * 2816 * 2;
constexpr size_t W_DSA = W_FO + 8 * W_FO_SZ;
constexpr size_t W_FOX = W_DSA + (size_t)1536 * 2048;
constexpr size_t W_SWA = W_FOX + (size_t)3328 * 2048;
constexpr size_t W_DIFF = W_SWA + (size_t)1280 * 2048;
constexpr size_t W_OUT = W_DIFF + (size_t)3072 * 2048;
static_assert(W_OUT + 4 * (size_t)1024 * 2048 <= 168 * MiB, "weights region");
constexpr int LDS_BYTES = 144 * 1024;
constexpr int LDS_MISC = 132 * 1024;
constexpr size_t WS_STATS = 768 * 1024;
constexpr size_t WS_CTLZ = 512 * 1024, CTLZ_BYTES = 256 * 1024;
constexpr int PAR_LNG = 0, PAR_LNB = 12288, PAR_KVN = 24576, PAR_KVUP = 24704, PAR_FB = 41088, PAR_SINK = 41104, PAR_LAM = 41120, PAR_SUBLN = 41376, PAR_ONE = 43008, PAR_ZERO = 44032, PAR_N = 45056;

__device__ __forceinline__ unsigned f2bf(float f) { unsigned u = __builtin_bit_cast(unsigned, f); return (u + 0x7fffu + ((u >> 16) & 1u)) >> 16; }
__device__ __forceinline__ unsigned pk2(float lo, float hi) { return pg8::cvt_pk_bf16(lo, hi); }
__device__ __forceinline__ float bf2f(unsigned short b) { return __builtin_bit_cast(float, (unsigned)b << 16); }
__device__ __forceinline__ float fast_exp2(float x) { return __builtin_amdgcn_exp2f(x); }
__device__ __forceinline__ float fast_rcp(float x) { return __builtin_amdgcn_rcpf(x); }
#define LDS_WAIT() asm volatile("s_waitcnt lgkmcnt(0)" ::: "memory")
__device__ __forceinline__ unsigned char* opq(unsigned char* p) { asm volatile("" : "+s"(p)); return p; }

#define XB_TMO      128
#define XB_XCNT(j)  (256  + 64 * (j))
#define XB_XSUB(j)  (1280 + 64 * (j))
#define XB_XGEN(j)  (2304 + 64 * (j))
#define XB_TOP      3328
#define XB_TOPGEN   3392
#define XCD_BAR_WORDS 3456
#define XB_SPIN_CAP (1u << 18)

__device__ __forceinline__ unsigned xb_ld(unsigned* p)              { return __hip_atomic_load(p, __ATOMIC_RELAXED, __HIP_MEMORY_SCOPE_AGENT); }
__device__ __forceinline__ unsigned xb_add(unsigned* p, unsigned v) { return __hip_atomic_fetch_add(p, v, __ATOMIC_RELAXED, __HIP_MEMORY_SCOPE_AGENT); }
__device__ __forceinline__ unsigned xb_xcc_id() { return (unsigned)__builtin_amdgcn_s_getreg((3 << 11) | 20) & 0xFu; }
#define XB_SPIN(cond, bar) do { unsigned _sp = 0; while (cond) { __builtin_amdgcn_s_sleep(1); \
    if ((++_sp & 255u) == 0u) { if (xb_ld(&(bar)[XB_TMO])) break; if (_sp > XB_SPIN_CAP) { atomicAdd(&(bar)[XB_TMO], 1u); break; } } } } while (0)

struct XcdBarrier {
    unsigned* bar; unsigned x;
    volatile LAS unsigned* st;
};

__device__ __forceinline__ XcdBarrier xcd_barrier_post(unsigned* bar, volatile LAS unsigned* st) {
    XcdBarrier b; b.bar = bar; b.x = xb_xcc_id(); b.st = st;
    if (threadIdx.x == 0) (void)xb_add(&bar[XB_XCNT(b.x)], 1u);
    return b;
}
__device__ __forceinline__ void xcd_barrier_complete(unsigned* bar, unsigned x, unsigned& nloc, unsigned& nx) {
    const unsigned G = gridDim.x * gridDim.y * gridDim.z;
    unsigned sum, cnt, mine, sp = 0u;
    for (;;) {
        sum = 0u; cnt = 0u; mine = 0u;
#pragma unroll
        for (unsigned j = 0; j < 16; ++j) { const unsigned c = xb_ld(&bar[XB_XCNT(j)]); sum += c; cnt += (c > 0u) ? 1u : 0u; mine = (j == x) ? c : mine; }
        if (sum == G) break;
        __builtin_amdgcn_s_sleep(1);
        if ((++sp & 255u) == 0u) { if (xb_ld(&bar[XB_TMO])) break; if (sp > XB_SPIN_CAP) { atomicAdd(&bar[XB_TMO], 1u); break; } }
    }
    nloc = mine > 0u ? mine : 1u; nx = cnt > 0u ? cnt : 1u;
}

__device__ __forceinline__ void xcd_barrier(const XcdBarrier& b) {
    asm volatile("s_waitcnt vmcnt(0)" ::: "memory");
    __syncthreads();
    if (threadIdx.x == 0) {
        unsigned* bar = b.bar;
        __builtin_amdgcn_s_waitcnt(0);
        unsigned nloc = b.st[0], nx = b.st[1];
        if (nloc == 0u) { xcd_barrier_complete(bar, b.x, nloc, nx); b.st[0] = nloc; b.st[1] = nx; }
        const unsigned old = xb_add(&bar[XB_XSUB(b.x)], 1u);
        const unsigned gen = old / nloc;
        if (old + 1u == (gen + 1u) * nloc) {
            __builtin_amdgcn_fence(__ATOMIC_RELEASE, "agent");
            asm volatile("s_waitcnt vmcnt(0)" ::: "memory");
            const unsigned og = xb_add(&bar[XB_TOP], 1u);
            const unsigned tg = og / nx;
            if (og + 1u == (tg + 1u) * nx) xb_add(&bar[XB_TOPGEN], 1u);
            else XB_SPIN(xb_ld(&bar[XB_TOPGEN]) == tg, bar);
            __builtin_amdgcn_fence(__ATOMIC_ACQUIRE, "agent");
            xb_add(&bar[XB_XGEN(b.x)], 1u);
            asm volatile("s_waitcnt vmcnt(0)" ::: "memory");
        } else {
            XB_SPIN(xb_ld(&bar[XB_XGEN(b.x)]) == gen, bar);
            __builtin_amdgcn_fence(__ATOMIC_ACQUIRE, "agent");
            asm volatile("s_waitcnt vmcnt(0)" ::: "memory");
        }
    }
    __syncthreads();
}

__device__ __forceinline__ void xsync(const XcdBarrier& b) { xcd_barrier(b); }
__device__ __forceinline__ int opq_i(int v) { asm volatile("" : "+s"(v)); return v; }
__device__ __forceinline__ void gsync(cg::grid_group& g) {
    asm volatile("s_waitcnt vmcnt(0) lgkmcnt(0)" ::: "memory");
    g.sync();
#if RPT_SYNC
    g.sync();
#endif
    __builtin_amdgcn_fence(__ATOMIC_ACQUIRE, "agent");
    asm volatile("s_waitcnt vmcnt(0)" ::: "memory");
}
struct EpiSwiGLU {
    static constexpr bool PERM = true, AFTER_DRAIN = false;
    bf16* O; int ldc;
    __device__ __forceinline__ void operator()(const f32x4 (&acc)[2][2][4][2], const pg8::Unit& u, int wr, int wc, int fr, int fq) const {
        const int row0 = u.pm * 256 + wr * 64 + fr, col0 = u.pn * 128 + wc * 32 + 8 * fq;
#pragma unroll
        for (int ai = 0; ai < 2; ++ai)
#pragma unroll
            for (int m = 0; m < 4; ++m) {
                bf16* rowp = O + (size_t)(row0 + ai * 128 + m * 16) * ldc + col0;
                float r[8];
#pragma unroll
                for (int n = 0; n < 2; ++n)
#pragma unroll
                    for (int i = 0; i < 4; ++i) { const float g = acc[ai][0][m][n][i], up = acc[ai][1][m][n][i];
                        r[n * 4 + i] = g * fast_rcp(1.0f + fast_exp2(-g * LOG2E)) * up; }
                u32x4 w; w.x = pk2(r[0], r[1]); w.y = pk2(r[2], r[3]); w.z = pk2(r[4], r[5]); w.w = pk2(r[6], r[7]);
                *(u32x4*)rowp = w;
            }
    }
};
template <int HALFW>
struct EpiResid {
    static constexpr bool PERM = true, AFTER_DRAIN = false;
    unsigned char* ws; const f16* xres; f16* out; int code;
    __device__ __forceinline__ void operator()(const f32x4 (&acc)[2][2][4][2], const pg8::Unit& u, int wr, int wc, int fr, int fq) const {
        typedef _Float16 f16x8 __attribute__((ext_vector_type(8))); typedef float f32x8 __attribute__((ext_vector_type(8)));
        const float w = HALFW ? 0.5f : 1.0f;
        const int b = u.pm >> 4; const float* gb = (const float*)(ws + WS_MOD) + (size_t)(code & 1023) * 1024 + (size_t)b * MODW;
        const float* lg = (const float*)ws + (size_t)((code >> 10) & 1023) * 1024; const float* lb = (const float*)ws + (size_t)((code >> 20) & 1023) * 1024;
        const float* stats = (const float*)(ws + WS_STATS);
        const int col0 = u.pn * 256 + wc * 32 + 8 * fq, rowb = u.pm * 256 + wr * 64 + fr;
        float mu[8], rs[8];
#pragma unroll
        for (int q = 0; q < 8; ++q) { const int row = rowb + (q >> 2) * 128 + (q & 3) * 16; mu[q] = stats[2 * row]; rs[q] = stats[2 * row + 1]; }
        f16x8 xin[2][2];
#define ER_LOAD(bt_, slot_) do { const int col_ = col0 + ((bt_) >> 2) * 128, r0_ = rowb + (((bt_) >> 1) & 1) * 128 + ((bt_) & 1) * 32; _Pragma("unroll") for (int m_ = 0; m_ < 2; ++m_) \
            xin[slot_][m_] = *(const f16x8*)(xres + (size_t)(r0_ + m_ * 16) * DM + col_); } while (0)
        ER_LOAD(0, 0);
#pragma unroll
        for (int bt = 0; bt < 8; ++bt) {
            const int bj = bt >> 2, ai = (bt >> 1) & 1, mp = bt & 1, col = col0 + bj * 128;
            const f32x4 gva = *(const f32x4*)(gb + col), gvb = *(const f32x4*)(gb + col + 4); const f32x4 gma = (gva + 1.0f) * w, gmb = (gvb + 1.0f) * w;
            const f32x4 g4a = *(const f32x4*)(lg + col), g4b = *(const f32x4*)(lg + col + 4), b4a = *(const f32x4*)(lb + col), b4b = *(const f32x4*)(lb + col + 4);
            if (bt + 1 < 8) ER_LOAD(bt + 1, (bt + 1) & 1);
#pragma unroll
            for (int mm = 0; mm < 2; ++mm) { const int m = 2 * mp + mm, q = ai * 4 + m; const size_t off = (size_t)(rowb + ai * 128 + m * 16) * DM + col;
                const f32x8 xf = __builtin_convertvector(xin[bt & 1][mm], f32x8);
                f32x4 xa = {xf[0], xf[1], xf[2], xf[3]}, xb = {xf[4], xf[5], xf[6], xf[7]};
                xa = (xa - mu[q]) * rs[q] * g4a + b4a; xb = (xb - mu[q]) * rs[q] * g4b + b4b;
                const f32x4 oa = xa * ALPHA + gma * acc[ai][bj][m][0], ob = xb * ALPHA + gmb * acc[ai][bj][m][1];
                const f32x8 of = {oa[0], oa[1], oa[2], oa[3], ob[0], ob[1], ob[2], ob[3]};
                *(f16x8*)(out + off) = __builtin_convertvector(of, f16x8); }
        }
#undef ER_LOAD
    }
};
struct EpiProj {
    static constexpr bool PERM = true, AFTER_DRAIN = false;
    bf16* O; int ldc;
    int q_end, rope_end, idx_lo, idx_hi, w_lo, f_lo;
    float* flog;
    const float *cos16, *sin16, *cos8, *sin8;
    __device__ __forceinline__ void operator()(const f32x4 (&acc)[2][2][4][2], const pg8::Unit& u, int wr, int wc, int fr, int fq) const {
#pragma unroll
        for (int bj = 0; bj < 2; ++bj) {
            const int cbase = u.pn * 256 + bj * 128 + wc * 32;
            const bool r64 = cbase < rope_end && (cbase & 63) == 0;
            const bool r32 = cbase >= idx_lo && cbase < idx_hi;
            const float sc = cbase < q_end ? C2 : 1.0f;
            const bool isw = cbase == w_lo, isf = cbase == f_lo;
#pragma unroll
            for (int ai = 0; ai < 2; ++ai)
#pragma unroll
                for (int m = 0; m < 4; ++m) {
                    const int row = u.pm * 256 + ai * 128 + wr * 64 + m * 16 + fr, pos = row & (SEQ - 1);
                    f32x4 v0 = acc[ai][bj][m][0], v1 = acc[ai][bj][m][1];
                    if (r64) {
                        f32x4 o0, o1;
#pragma unroll
                        for (int i = 0; i < 4; ++i) { o0[i] = __shfl_xor(v0[i], 16); o1[i] = __shfl_xor(v1[i], 16); }
                        if (fq < 2) {
                            const f32x4 c0 = *(const f32x4*)(cos16 + pos * 8), c1 = *(const f32x4*)(cos16 + pos * 8 + 4);
                            const f32x4 s0 = *(const f32x4*)(sin16 + pos * 8), s1 = *(const f32x4*)(sin16 + pos * 8 + 4);
                            const float sg = fq == 0 ? -1.0f : 1.0f;
                            v0 = v0 * c0 + (o0 * s0) * sg; v1 = v1 * c1 + (o1 * s1) * sg;
                        }
                    }
                    if (r32 && fq == 0) {
                        const f32x4 c = *(const f32x4*)(cos8 + pos * 4), s = *(const f32x4*)(sin8 + pos * 4);
                        const f32x4 n0 = v0 * c - v1 * s, n1 = v1 * c + v0 * s; v0 = n0; v1 = n1;
                    }
                    if (isw && fq == 0) { v0 = v0 * 0.0625f; v1 = v1 * 0.0625f; }
                    if (isf && fq < 2) { *(f32x4*)(flog + (size_t)row * 16 + 8 * fq) = v0; *(f32x4*)(flog + (size_t)row * 16 + 8 * fq + 4) = v1; }
                    v0 = v0 * sc; v1 = v1 * sc;
                    u32x4 w; w.x = pk2(v0[0], v0[1]); w.y = pk2(v0[2], v0[3]); w.z = pk2(v1[0], v1[1]); w.w = pk2(v1[2], v1[3]);
                    *(u32x4*)(O + (size_t)row * ldc + cbase + 8 * fq) = w;
                }
        }
    }
};

__device__ __forceinline__ float wave_sum(float v) {
#pragma unroll
    for (int o = 1; o < 64; o <<= 1) v += __shfl_xor(v, o);
    return v;
}
__device__ __forceinline__ int wave_isum(int v) {
#pragma unroll
    for (int o = 1; o < 64; o <<= 1) v += __shfl_xor(v, o);
    return v;
}
struct ConvDesc { const float* W; bf16* WT; int K, N, Npad, item; bool ffn; };
__device__ __forceinline__ void conv_load(const ConvDesc& d, int lane, f32x4 (&ld)[8]) {
    const int nblk = d.Npad / 32, kb = d.item / nblk, nb = d.item % nblk, k0 = 64 * kb, n0 = 32 * nb;
    int sc0 = n0; if (d.ffn) { const int t = n0 >> 8, s = (n0 >> 7) & 1, r = n0 & 127; sc0 = s * FF + 128 * t + r; }
    const int c4 = lane & 7, col = sc0 + 4 * c4; const bool ok = col < d.N;
#pragma unroll
    for (int i = 0; i < 8; ++i) { const int kk = (lane >> 3) + 8 * i; ld[i] = ok ? *(const f32x4*)(d.W + (size_t)(k0 + kk) * d.N + col) : (f32x4){0.f, 0.f, 0.f, 0.f}; }
}
__device__ __forceinline__ void conv_store(const ConvDesc& d, LAS float* scr, int lane, const f32x4 (&ld)[8]) {
    const int nblk = d.Npad / 32, kb = d.item / nblk, nb = d.item % nblk, k0 = 64 * kb, n0 = 32 * nb, c4 = lane & 7;
#pragma unroll
    for (int i = 0; i < 8; ++i) { const int kk = (lane >> 3) + 8 * i; LAS float* p = scr + kk * 33 + 4 * c4; p[0] = ld[i][0]; p[1] = ld[i][1]; p[2] = ld[i][2]; p[3] = ld[i][3]; }
    LDS_WAIT(); asm volatile("" ::: "memory");
    const int c = lane & 7;
#pragma unroll
    for (int j = 0; j < 4; ++j) { const int n = (lane >> 3) + 8 * j; const LAS float* s = scr + (8 * c) * 33 + n;
        u32x4 o; o.x = pk2(s[0 * 33], s[1 * 33]); o.y = pk2(s[2 * 33], s[3 * 33]); o.z = pk2(s[4 * 33], s[5 * 33]); o.w = pk2(s[6 * 33], s[7 * 33]);
        *(u32x4*)(d.WT + (size_t)(n0 + n) * d.K + k0 + 8 * c) = o; }
    LDS_WAIT(); asm volatile("" ::: "memory");
}
template <bool SRC16>
__device__ __forceinline__ void ln_rows(const void* srcv, f16* v16out, float* xout, bf16* hout, const float* g, const float* bt, const float* scale, const float* shift,
                                        bool do_ln, bool write_h, float pre, float* stats, bool write_x) {
    int tid_ = threadIdx.x; asm volatile("" : "+v"(tid_));
    const int lane = tid_ & 63, gw = blockIdx.x * NWAVES + __builtin_amdgcn_readfirstlane(tid_ >> 6), ngw = gridDim.x * NWAVES;
    typedef _Float16 f16x8 __attribute__((ext_vector_type(8))); typedef float f32x8 __attribute__((ext_vector_type(8)));
#define FI(j) (2 * lane + 128 * ((j) >> 1) + ((j) & 1))
    f16x8 nx16[4][2]; f32x4 nx32[4][4];
#define LN_LOAD(mbase) do { _Pragma("unroll") for (int r = 0; r < 4; ++r) { const int mr_ = (mbase) + r; const int mc_ = mr_ < M ? mr_ : (mbase); \
        if (SRC16) { const f16x8* xr = (const f16x8*)((const f16*)srcv + (size_t)mc_ * DM) + lane; _Pragma("unroll") for (int jj = 0; jj < 2; ++jj) nx16[r][jj] = xr[64 * jj]; } \
        else { const f32x4* xr = (const f32x4*)((const float*)srcv + (size_t)mc_ * DM); _Pragma("unroll") for (int j = 0; j < 4; ++j) nx32[r][j] = xr[FI(j)]; } } } while (0)
    if (4 * gw < M) LN_LOAD(4 * gw);
    for (int m0 = 4 * gw; m0 < M; m0 += 4 * ngw) {
        int mm[4]; bool has[4];
#pragma unroll
        for (int r = 0; r < 4; ++r) { const int mr = m0 + r; has[r] = mr < M; mm[r] = has[r] ? mr : m0; }
        f32x4 v[4][4];
#pragma unroll
        for (int r = 0; r < 4; ++r) {
            if (SRC16) {
#pragma unroll
                for (int jj = 0; jj < 2; ++jj) { const f32x8 f = __builtin_convertvector(nx16[r][jj], f32x8);
                    v[r][2 * jj] = (f32x4){f[0], f[1], f[2], f[3]} * pre; v[r][2 * jj + 1] = (f32x4){f[4], f[5], f[6], f[7]} * pre; }
            } else {
#pragma unroll
                for (int j = 0; j < 4; ++j) v[r][j] = nx32[r][j] * pre;
            }
        }
        if (m0 + 4 * ngw < M) LN_LOAD(m0 + 4 * ngw);
#pragma unroll
        for (int r = 0; r < 4; ++r) {
            if (!has[r]) continue;
            const int m = mm[r], b = m >> 12;
            if (!do_ln && stats && lane == 0) { stats[2 * m] = 0.f; stats[2 * m + 1] = 1.f; }
            if (!SRC16 && v16out) { f16x8* vo = (f16x8*)(v16out + (size_t)m * DM) + lane;
#pragma unroll
                for (int jj = 0; jj < 2; ++jj) { const f32x4 a0 = v[r][2 * jj], a1 = v[r][2 * jj + 1]; const f32x8 f = {a0[0], a0[1], a0[2], a0[3], a1[0], a1[1], a1[2], a1[3]};
                    vo[64 * jj] = __builtin_convertvector(f, f16x8); } }
            if (do_ln) {
                float s = 0.f;
#pragma unroll
                for (int j = 0; j < 4; ++j) s += (v[r][j][0] + v[r][j][1]) + (v[r][j][2] + v[r][j][3]);
                const float mean = wave_sum(s) * (1.f / DM); float s2 = 0.f;
#pragma unroll
                for (int j = 0; j < 4; ++j) { v[r][j] = v[r][j] - mean; s2 += (v[r][j][0] * v[r][j][0] + v[r][j][1] * v[r][j][1]) + (v[r][j][2] * v[r][j][2] + v[r][j][3] * v[r][j][3]); }
                const float rstd = 1.0f / sqrtf(wave_sum(s2) * (1.f / DM) + LN_EPS);
                if (stats && lane == 0) { stats[2 * m] = mean; stats[2 * m + 1] = rstd; }
                f32x4* xo = (f32x4*)(xout + (size_t)m * DM);
#pragma unroll
                for (int j = 0; j < 4; ++j) { const f32x4 gg = *((const f32x4*)g + FI(j)), bb = *((const f32x4*)bt + FI(j));
                    v[r][j] = v[r][j] * rstd * gg + bb; if (write_x) xo[FI(j)] = v[r][j]; }
            }
            if (write_h) {
                const f32x4* sc = (const f32x4*)(scale + (size_t)b * MODW); const f32x4* sh = (const f32x4*)(shift + (size_t)b * MODW);
                u32x4* ho = (u32x4*)(hout + (size_t)m * DM) + lane;
#pragma unroll
                for (int jj = 0; jj < 2; ++jj) { const f32x4 h0 = v[r][2 * jj] * (sc[FI(2 * jj)] + 1.0f) + sh[FI(2 * jj)], h1 = v[r][2 * jj + 1] * (sc[FI(2 * jj + 1)] + 1.0f) + sh[FI(2 * jj + 1)];
                    u32x4 w; w.x = pk2(h0[0], h0[1]); w.y = pk2(h0[2], h0[3]); w.z = pk2(h1[0], h1[1]); w.w = pk2(h1[2], h1[3]); ho[64 * jj] = w; }
            }
        }
    }
#undef LN_LOAD
#undef FI
}
constexpr int KROW = 144;
__device__ __forceinline__ f32x16 mfma32(bf16x8 a, bf16x8 b, f32x16 c) { return __builtin_amdgcn_mfma_f32_32x32x16_bf16(a, b, c, 0, 0, 0); }

template <int DV, int MODE>
__device__ __forceinline__ void attn_tile(LAS const unsigned char* Kb, const bf16x8 (&qr)[4], f32x16 (&o)[DV / 32], float& m, float& l,
                                          const int t, const int q0, const int wid, const int r32, const int hi, const int qpos, const unsigned long long (&bw)[4]) {
    constexpr int KB = 64 * KROW, VB = DV * KROW;
    LAS const unsigned char* VTb = Kb + KB; LAS const float* Bb = (LAS const float*)(Kb + KB + VB);
    f32x16 p[2];
#pragma unroll
    for (int half = 0; half < 2; ++half) {
        if (MODE == 0) {
#pragma unroll
            for (int g = 0; g < 4; ++g) { const f32x4 bv = *(LAS const f32x4*)(Bb + 32 * half + 8 * g + 4 * hi);
                p[half][4 * g] = bv[0]; p[half][4 * g + 1] = bv[1]; p[half][4 * g + 2] = bv[2]; p[half][4 * g + 3] = bv[3]; }
        } else {
#pragma unroll
            for (int r = 0; r < 16; ++r) p[half][r] = 0.f;
        }
#pragma unroll
        for (int d0 = 0; d0 < 4; ++d0) { const bf16x8 kf = *(LAS const bf16x8*)(Kb + (32 * half + r32) * KROW + (2 * d0 + hi) * 16); p[half] = mfma32(kf, qr[d0], p[half]); }
    }
    const int kv0 = 64 * t + 4 * hi;
    if (MODE == 0 || MODE == 1) {
        if (64 * t + 63 > q0 + 32 * wid) {
#pragma unroll
            for (int half = 0; half < 2; ++half)
#pragma unroll
                for (int r = 0; r < 16; ++r) { const int kv = kv0 + 32 * half + 8 * (r >> 2) + (r & 3); if (kv > qpos) p[half][r] = NEGBIG; }
        }
    }
    if (MODE == 2) {
#pragma unroll
        for (int half = 0; half < 2; ++half)
#pragma unroll
            for (int r = 0; r < 16; ++r) { const int d = qpos - (kv0 + 32 * half + 8 * (r >> 2) + (r & 3)); if (d < 0 || d >= 128) p[half][r] = NEGBIG; }
    }
    if (MODE == 3) {
        unsigned wsh[4];
#pragma unroll
        for (int i = 0; i < 4; ++i) wsh[i] = (unsigned)(bw[i] >> (16 * (t & 3) + hi));
#pragma unroll
        for (int half = 0; half < 2; ++half)
#pragma unroll
            for (int r = 0; r < 16; ++r) { if (!((wsh[r & 3] >> (8 * half + 2 * (r >> 2))) & 1u)) p[half][r] = NEGBIG; }
    }
    float mx = fmaxf(p[0][0], p[1][0]);
#pragma unroll
    for (int r = 1; r < 16; ++r) mx = fmaxf(mx, fmaxf(p[0][r], p[1][r]));
    mx = fmaxf(mx, __shfl_xor(mx, 32));
    const float mnew = fmaxf(m, mx);
    if (!__all(mnew == m)) {
        const float alpha = fast_exp2(m - mnew); l *= alpha; m = mnew;
#pragma unroll
        for (int dh = 0; dh < DV / 32; ++dh)
#pragma unroll
            for (int r = 0; r < 16; ++r) o[dh][r] *= alpha;
    }
    float ls = 0.f;
#pragma unroll
    for (int half = 0; half < 2; ++half)
#pragma unroll
        for (int r = 0; r < 16; ++r) { const float e = fast_exp2(p[half][r] - m); p[half][r] = e; ls += e; }
    l += ls;
#pragma unroll
    for (int half = 0; half < 2; ++half)
#pragma unroll
        for (int c = 0; c < 2; ++c) {
            u32x4 pw; pw.x = pk2(p[half][8 * c], p[half][8 * c + 1]); pw.y = pk2(p[half][8 * c + 2], p[half][8 * c + 3]);
            pw.z = pk2(p[half][8 * c + 4], p[half][8 * c + 5]); pw.w = pk2(p[half][8 * c + 6], p[half][8 * c + 7]);
            const bf16x8 pf = __builtin_bit_cast(bf16x8, pw);
#pragma unroll
            for (int dh = 0; dh < DV / 32; ++dh) { const bf16x8 vf = *(LAS const bf16x8*)(VTb + (32 * dh + r32) * KROW + (32 * half + 16 * c + 8 * hi) * 2); o[dh] = mfma32(vf, pf, o[dh]); }
        }
}

template <int DV, int MODE>
__device__ __forceinline__ void attn_core(LAS unsigned char* lds, const bf16* Qrow, const bf16* Kp, int ldk, const bf16* Vp, int ldv,
                                          const float* kb, const unsigned long long* bmrow, int q0, int t_lo, int t_hi, float m_init, float l_init,
                                          f32x16 (&o)[DV / 32], float& l_out) {
    int tid_ = threadIdx.x; asm volatile("" : "+v"(tid_));
    const int tid = tid_, lane = tid & 63, wid = __builtin_amdgcn_readfirstlane(tid >> 6), r32 = lane & 31, hi = lane >> 5;
    constexpr int KB = 64 * KROW, VB = DV * KROW, BUF = KB + VB + 256, NV = DV / 64;
    bf16x8 qr[4];
#pragma unroll
    for (int d0 = 0; d0 < 4; ++d0) qr[d0] = *(const bf16x8*)(Qrow + 16 * d0 + 8 * hi);
    const int qpos = q0 + 32 * wid + r32;
    float m = m_init, l = (hi == 0) ? l_init : 0.f;
#pragma unroll
    for (int dh = 0; dh < DV / 32; ++dh)
#pragma unroll
        for (int r = 0; r < 16; ++r) o[dh][r] = 0.f;
    const int krow = tid >> 3, kch = tid & 7, vkv = lane, vch = wid;
    const int vpos = (vkv & ~15) | (((vkv >> 2) & 1) << 3) | (((vkv >> 3) & 1) << 2) | (vkv & 3);
    u32x4 kregA, kregB, vregA[NV], vregB[NV]; float bregA = 0.f, bregB = 0.f;
#define AT_GLOAD(R, t) do { kreg##R = *(const u32x4*)(Kp + (size_t)(64 * (t) + krow) * ldk + kch * 8); \
        _Pragma("unroll") for (int i_ = 0; i_ < NV; ++i_) vreg##R[i_] = *(const u32x4*)(Vp + (size_t)(64 * (t) + vkv) * ldv + (vch + 8 * i_) * 8); \
        if (MODE == 0) { if (tid < 64) breg##R = kb[64 * (t) + tid]; } } while (0)
#define AT_LSTORE(R, buf) do { LAS unsigned char* b_ = lds + (buf) * BUF; *(LAS u32x4*)(b_ + krow * KROW + kch * 16) = kreg##R; \
        _Pragma("unroll") for (int i_ = 0; i_ < NV; ++i_) _Pragma("unroll") for (int j_ = 0; j_ < 8; ++j_) \
            *(LAS unsigned short*)(b_ + KB + ((vch + 8 * i_) * 8 + j_) * KROW + vpos * 2) = (unsigned short)(vreg##R[i_][j_ >> 1] >> (16 * (j_ & 1))); \
        if (MODE == 0) { if (tid < 64) *(LAS float*)(b_ + KB + VB + tid * 4) = breg##R; } } while (0)
#define AT_NEED(t) ((64 * (t) <= q0 + 32 * wid + 31) && (MODE != 2 || (64 * (t) + 63 >= q0 + 32 * wid - 127)))
    unsigned long long bw[4] = {0ull, 0ull, 0ull, 0ull}, bwn[4] = {0ull, 0ull, 0ull, 0ull};
#define AT_MASK(tt) do { if (MODE == 3) { if (((tt) & 3) == 0) { _Pragma("unroll") for (int i_ = 0; i_ < 4; ++i_) bw[i_] = bwn[i_]; } \
        if (((tt) & 3) == 3 && (tt) + 1 < t_hi) { _Pragma("unroll") for (int i_ = 0; i_ < 4; ++i_) bwn[i_] = bmrow[4 * (((tt) + 1) >> 2) + i_]; } } } while (0)
    if (MODE == 3) {
#pragma unroll
        for (int i = 0; i < 4; ++i) bwn[i] = bmrow[4 * (t_lo >> 2) + i]; }
    AT_GLOAD(A, t_lo); if (t_lo + 1 < t_hi) AT_GLOAD(B, t_lo + 1);
    AT_LSTORE(A, 0); __syncthreads();
    for (int t = t_lo; t < t_hi; t += 2) {
        AT_MASK(t);
        if (t + 2 < t_hi) AT_GLOAD(A, t + 2);
        if (AT_NEED(t)) attn_tile<DV, MODE>(lds, qr, o, m, l, t, q0, wid, r32, hi, qpos, bw);
        if (t + 1 < t_hi) AT_LSTORE(B, 1);
        __syncthreads();
        if (t + 1 >= t_hi) break;
        AT_MASK(t + 1);
        if (t + 3 < t_hi) AT_GLOAD(B, t + 3);
        if (AT_NEED(t + 1)) attn_tile<DV, MODE>(lds + BUF, qr, o, m, l, t + 1, q0, wid, r32, hi, qpos, bw);
        if (t + 2 < t_hi) AT_LSTORE(A, 0);
        __syncthreads();
    }
#undef AT_GLOAD
#undef AT_LSTORE
#undef AT_NEED
#undef AT_MASK
    l_out = l + __shfl_xor(l, 32);
}
template <int DV, int MODE>
__device__ __forceinline__ void attn_core_h2(LAS unsigned char* lds, const bf16* Qrow, const bf16* Qrow2, const bf16* Kp, int ldk, const bf16* Vp, int ldv,
                                          const float* kb, const unsigned long long* bmrow, int q0, int t_lo, int t_hi, float m_init, float l_init,
                                          f32x16 (&o)[DV / 32], float& l_out, f32x16 (&o2)[DV / 32], float& l_out2) {
    int tid_ = threadIdx.x; asm volatile("" : "+v"(tid_));
    const int tid = tid_, lane = tid & 63, wid = __builtin_amdgcn_readfirstlane(tid >> 6), r32 = lane & 31, hi = lane >> 5;
    constexpr int KB = 64 * KROW, VB = DV * KROW, BUF = KB + VB + 256, NV = DV / 64;
    bf16x8 qr[4], qr2[4];
#pragma unroll
    for (int d0 = 0; d0 < 4; ++d0) { qr[d0] = *(const bf16x8*)(Qrow + 16 * d0 + 8 * hi); qr2[d0] = *(const bf16x8*)(Qrow2 + 16 * d0 + 8 * hi); }
    const int qpos = q0 + 32 * wid + r32;
    float m = m_init, l = (hi == 0) ? l_init : 0.f, m2 = m_init, l2 = l;
#pragma unroll
    for (int dh = 0; dh < DV / 32; ++dh)
#pragma unroll
        for (int r = 0; r < 16; ++r) { o[dh][r] = 0.f; o2[dh][r] = 0.f; }
    const int krow = tid >> 3, kch = tid & 7, vkv = lane, vch = wid;
    const int vpos = (vkv & ~15) | (((vkv >> 2) & 1) << 3) | (((vkv >> 3) & 1) << 2) | (vkv & 3);
    u32x4 kregA, kregB, vregA[NV], vregB[NV]; float bregA = 0.f, bregB = 0.f;
#define AT_GLOAD(R, t) do { kreg##R = *(const u32x4*)(Kp + (size_t)(64 * (t) + krow) * ldk + kch * 8); \
        _Pragma("unroll") for (int i_ = 0; i_ < NV; ++i_) vreg##R[i_] = *(const u32x4*)(Vp + (size_t)(64 * (t) + vkv) * ldv + (vch + 8 * i_) * 8); \
        if (MODE == 0) { if (tid < 64) breg##R = kb[64 * (t) + tid]; } } while (0)
#define AT_LSTORE(R, buf) do { LAS unsigned char* b_ = lds + (buf) * BUF; *(LAS u32x4*)(b_ + krow * KROW + kch * 16) = kreg##R; \
        _Pragma("unroll") for (int i_ = 0; i_ < NV; ++i_) _Pragma("unroll") for (int j_ = 0; j_ < 8; ++j_) \
            *(LAS unsigned short*)(b_ + KB + ((vch + 8 * i_) * 8 + j_) * KROW + vpos * 2) = (unsigned short)(vreg##R[i_][j_ >> 1] >> (16 * (j_ & 1))); \
        if (MODE == 0) { if (tid < 64) *(LAS float*)(b_ + KB + VB + tid * 4) = breg##R; } } while (0)
#define AT_NEED(t) ((64 * (t) <= q0 + 32 * wid + 31) && (MODE != 2 || (64 * (t) + 63 >= q0 + 32 * wid - 127)))
    unsigned long long bw[4] = {0ull, 0ull, 0ull, 0ull}, bwn[4] = {0ull, 0ull, 0ull, 0ull};
#define AT_MASK(tt) do { if (MODE == 3) { if (((tt) & 3) == 0) { _Pragma("unroll") for (int i_ = 0; i_ < 4; ++i_) bw[i_] = bwn[i_]; } \
        if (((tt) & 3) == 3 && (tt) + 1 < t_hi) { _Pragma("unroll") for (int i_ = 0; i_ < 4; ++i_) bwn[i_] = bmrow[4 * (((tt) + 1) >> 2) + i_]; } } } while (0)
    if (MODE == 3) {
#pragma unroll
        for (int i = 0; i < 4; ++i) bwn[i] = bmrow[4 * (t_lo >> 2) + i]; }
    AT_GLOAD(A, t_lo); if (t_lo + 1 < t_hi) AT_GLOAD(B, t_lo + 1);
    AT_LSTORE(A, 0); __syncthreads();
    for (int t = t_lo; t < t_hi; t += 2) {
        AT_MASK(t);
        if (t + 2 < t_hi) AT_GLOAD(A, t + 2);
        if (AT_NEED(t)) { attn_tile<DV, MODE>(lds, qr, o, m, l, t, q0, wid, r32, hi, qpos, bw); attn_tile<DV, MODE>(lds, qr2, o2, m2, l2, t, q0, wid, r32, hi, qpos, bw); }
        if (t + 1 < t_hi) AT_LSTORE(B, 1);
        __syncthreads();
        if (t + 1 >= t_hi) break;
        AT_MASK(t + 1);
        if (t + 3 < t_hi) AT_GLOAD(B, t + 3);
        if (AT_NEED(t + 1)) { attn_tile<DV, MODE>(lds + BUF, qr, o, m, l, t + 1, q0, wid, r32, hi, qpos, bw); attn_tile<DV, MODE>(lds + BUF, qr2, o2, m2, l2, t + 1, q0, wid, r32, hi, qpos, bw); }
        if (t + 2 < t_hi) AT_LSTORE(A, 0);
        __syncthreads();
    }
#undef AT_GLOAD
#undef AT_LSTORE
#undef AT_NEED
#undef AT_MASK
    l_out = l + __shfl_xor(l, 32); l_out2 = l2 + __shfl_xor(l2, 32);
}
template <int DV>
__device__ __forceinline__ void store_o(const f32x16 (&o)[DV / 32], float inv, bf16* orow, int hi) {
#pragma unroll
    for (int dh = 0; dh < DV / 32; ++dh)
#pragma unroll
        for (int g = 0; g < 4; ++g) { u32x2 w; w.x = pk2(o[dh][4 * g] * inv, o[dh][4 * g + 1] * inv); w.y = pk2(o[dh][4 * g + 2] * inv, o[dh][4 * g + 3] * inv);
            *(u32x2*)(orow + 32 * dh + 8 * g + 4 * hi) = w; }
}


__device__ __forceinline__ size_t sc_rowoff(int b, int q) { const int Gq = q >> 8; return (size_t)b * 8912896 + (size_t)65536 * (Gq * (Gq + 1) / 2) + (size_t)(q & 255) * 256 * (Gq + 1); }
__device__ __forceinline__ void select_load(const float* srow, const int nj, const int lane, f32x4 (&raw)[16]) {
#pragma unroll
    for (int j = 0; j < 16; ++j) { if (j < nj) raw[j] = *(const f32x4*)(srow + 256 * j + 4 * lane); }
}
__device__ __forceinline__ unsigned long long select_row(const f32x4 (&raw)[16], const int t, const int nj, const int lane) {
                unsigned key[16][4];
#pragma unroll
                for (int j = 0; j < 16; ++j) {
                    if (j < nj) {
#pragma unroll
                        for (int i = 0; i < 4; ++i) { const float fv = raw[j][i]; const unsigned uu = __float_as_uint(fv); const unsigned k = (uu & 0x80000000u) ? ~uu : (uu | 0x80000000u);
                            key[j][i] = (256 * j + 4 * lane + i <= t) ? k : 0u; } }
                    else { key[j][0] = 0u; key[j][1] = 0u; key[j][2] = 0u; key[j][3] = 0u; }
                }
                unsigned tau = 1u, I = 0xFFFFFFFFu;
                if (t >= 256) {
                    bool early = false; unsigned prefix = 0u, krem = 256u, msz = (unsigned)t + 1u;
#pragma unroll 1
                    for (int bit = 31; bit >= 0; --bit) {
                        const unsigned cand = prefix | (1u << bit), mh = ~((1u << bit) - 1u); int cnt = 0;
#pragma unroll
                        for (int j = 0; j < 16; ++j) if (j < nj) {
#pragma unroll
                            for (int i = 0; i < 4; ++i) cnt += (int)__popcll(__ballot((key[j][i] & mh) == cand));
                            __builtin_amdgcn_sched_barrier(0); }
                        if ((unsigned)cnt >= krem) { prefix = cand; msz = (unsigned)cnt; } else { krem -= (unsigned)cnt; msz -= (unsigned)cnt; }
                        if (msz == krem) { early = true; break; }
                    }
                    tau = prefix; int ceq = 0;
                    if (!early) {
#pragma unroll
                    for (int j = 0; j < 16; ++j) if (j < nj) {
#pragma unroll
                        for (int i = 0; i < 4; ++i) ceq += (key[j][i] == tau) ? 1 : 0;
                        __builtin_amdgcn_sched_barrier(0); }
                    ceq = wave_isum(ceq); }
                    if ((unsigned)ceq > krem) {
                        unsigned pre = 0u, nd = krem;
#pragma unroll 1
                        for (int bit = 11; bit >= 0; --bit) {
                            const unsigned mh = (~((1u << bit) - 1u)) & 0xFFFu; int cnt = 0;
#pragma unroll
                            for (int j = 0; j < 16; ++j) if (j < nj) {
#pragma unroll
                                for (int i = 0; i < 4; ++i) cnt += (key[j][i] == tau && (((unsigned)(256 * j + 4 * lane + i)) & mh) == pre) ? 1 : 0;
                                __builtin_amdgcn_sched_barrier(0); }
                            cnt = wave_isum(cnt);
                            if ((unsigned)cnt < nd) { nd -= (unsigned)cnt; pre |= 1u << bit; }
                        }
                        I = pre;
                    }
                }
                unsigned long long myw = 0ull;
#pragma unroll
                for (int j = 0; j < 16; ++j) if (j < nj) {
#pragma unroll
                    for (int i = 0; i < 4; ++i) { const unsigned idx = (unsigned)(256 * j + 4 * lane + i);
                        const unsigned long long w = __ballot(key[j][i] > tau || (key[j][i] == tau && idx <= I)); if (lane == 4 * j + i) myw = w; }
                    __builtin_amdgcn_sched_barrier(0); }
                return myw;
}
#ifdef ORACLE
__device__ __forceinline__ float wave_max(float v) {
#pragma unroll
    for (int o = 1; o < 64; o <<= 1) v = fmaxf(v, __shfl_xor(v, o));
    return v;
}
__device__ __forceinline__ void oracle_row(const int MODE, const int DV, const bf16* Qrow, const bf16* Kp, int ldk, const bf16* Vp, int ldv, const float* kb, const unsigned long long* bmrow,
                                           int t, float m_init, float l_init, float& o0, float& o1) {
    const int lane = threadIdx.x & 63;
    const float q = bf2f(Qrow[lane]);
    float m = m_init, l = l_init, a0 = 0.f, a1 = 0.f;
#pragma unroll 1
    for (int k = 0; k <= t; ++k) {
        if (MODE == 2 && t - k >= 128) continue;
        if (MODE == 3) { const int j = k >> 8, i = k & 3, lb = (k & 255) >> 2; if (!((bmrow[4 * j + i] >> lb) & 1ull)) continue; }
        float s = wave_sum(q * bf2f(Kp[(size_t)k * ldk + lane]));
        if (MODE == 0) s += kb[k];
        const float mn = fmaxf(m, s), al = exp2f(m - mn), e = exp2f(s - mn);
        l = l * al + e; a0 = a0 * al + e * bf2f(Vp[(size_t)k * ldv + lane]);
        if (DV == 128) a1 = a1 * al + e * bf2f(Vp[(size_t)k * ldv + 64 + lane]);
        m = mn;
    }
    o0 = a0 / l; o1 = a1 / l;
}
__device__ __forceinline__ void oracle_flag(unsigned char* ws, float err2, float ref2, int bit) {
    if ((threadIdx.x & 63) == 0 && !(err2 <= 0.0025f * ref2)) atomicOr((unsigned*)(ws + 900 * 1024), 1u << bit);
}
#endif
#ifdef ORACLE
__device__ __forceinline__ void oracle_check(unsigned char* ws_in, int L) {
    unsigned char* ws = opq(ws_in);
    int tid_ = threadIdx.x; asm volatile("" : "+v"(tid_));
    const int lane = tid_ & 63, gw = blockIdx.x * NWAVES + __builtin_amdgcn_readfirstlane(tid_ >> 6);
    const float* par = (const float*)ws; const bf16* ATT = (const bf16*)(ws + WS_ATT); const bf16* P = (const bf16*)(ws + WS_BIG);
    if (gw < 32) {
        const int ob = gw & 7, oh = (gw * 5) & 15, ti = (gw >> 2) & 7;
        const int ot = ti == 0 ? 3 : ti == 1 ? 77 : ti == 2 ? 255 : ti == 3 ? 256 : ti == 4 ? 700 : ti == 5 ? 1500 : ti == 6 ? 3000 : 4095;
        const size_t orow = (size_t)ob * SEQ + ot; float x0, x1;
        if (L == 0) {
            const bf16* KD = (const bf16*)(ws + WS_KD); const bf16* VD = (const bf16*)(ws + WS_VD); const unsigned long long* BM = (const unsigned long long*)(ws + WS_BM); const float* SC = (const float*)(ws + WS_SC);
            oracle_row(3, 64, P + orow * 1536 + oh * 64, KD + (size_t)ob * SEQ * 64, 64, VD + (size_t)ob * SEQ * 64, 64, nullptr, BM + orow * 64, ot, NEGBIG, 0.f, x0, x1);
            const float y = bf2f(ATT[orow * DM + oh * 64 + lane]);
            oracle_flag(ws, wave_sum((x0 - y) * (x0 - y)), wave_sum(x0 * x0), 0);
            const float* srow = SC + sc_rowoff(ob, ot); float mins = 3e38f, maxu = -3e38f; int cnt = 0;
            for (int k = lane; k <= ot; k += 64) { const int j = k >> 8, i = k & 3, lb = (k & 255) >> 2; const bool sel = (BM[orow * 64 + 4 * j + i] >> lb) & 1ull; const float s = srow[k];
                if (sel) { mins = fminf(mins, s); ++cnt; } else maxu = fmaxf(maxu, s); }
            cnt = wave_isum(cnt); mins = -wave_max(-mins); maxu = wave_max(maxu);
            const int want = ot + 1 < 256 ? ot + 1 : 256;
            oracle_flag(ws, (cnt == want && mins >= maxu) ? 0.f : 1.f, 1.f, 4);
        } else if (L == 1) {
            const float* CT = (const float*)(ws + WS_CUMT); const bf16* Pb = P + (size_t)ob * SEQ * 3328;
            oracle_row(0, 64, P + orow * 3328 + oh * 64, Pb + 1024 + oh * 64, 3328, Pb + 2048 + oh * 64, 3328, CT + (size_t)(ob * 16 + oh) * SEQ, nullptr, ot, NEGBIG, 0.f, x0, x1);
            const float y = bf2f(ATT[orow * DM + oh * 64 + lane]);
            oracle_flag(ws, wave_sum((x0 - y) * (x0 - y)), wave_sum(x0 * x0), 1);
        } else if (L == 2) {
            const bf16* Pb = P + (size_t)ob * SEQ * 1280; const int gk = oh >> 3;
            oracle_row(2, 64, P + orow * 1280 + oh * 64, Pb + 1024 + gk * 64, 1280, Pb + 1152 + gk * 64, 1280, nullptr, nullptr, ot, par[PAR_SINK + oh] * LOG2E, 1.0f, x0, x1);
            const float y = bf2f(ATT[orow * DM + oh * 64 + lane]);
            oracle_flag(ws, wave_sum((x0 - y) * (x0 - y)), wave_sum(x0 * x0), 2);
        } else {
            const bf16* Pb = P + (size_t)ob * SEQ * 3072; const int hh = oh & 7; float z0, z1;
            const float lambda_init = 0.8f - 0.6f * 0.40656965974059911f;
            const float s01 = wave_sum(par[PAR_LAM + lane] * par[PAR_LAM + 64 + lane]), s23 = wave_sum(par[PAR_LAM + 128 + lane] * par[PAR_LAM + 192 + lane]);
            const float lam = expf(s01) - expf(s23) + lambda_init;
            oracle_row(1, 128, P + orow * 3072 + (2 * hh) * 64, Pb + 1024 + (2 * hh) * 64, 3072, Pb + 2048 + hh * 128, 3072, nullptr, nullptr, ot, NEGBIG, 0.f, x0, x1);
            oracle_row(1, 128, P + orow * 3072 + (2 * hh + 1) * 64, Pb + 1024 + (2 * hh + 1) * 64, 3072, Pb + 2048 + hh * 128, 3072, nullptr, nullptr, ot, NEGBIG, 0.f, z0, z1);
            float v0 = x0 - lam * z0, v1 = x1 - lam * z1; const float ss = wave_sum(v0 * v0 + v1 * v1);
            const float rs = (1.0f / sqrtf(ss * (1.0f / 128.0f) + 1e-6f)) * (1.0f - lambda_init);
            v0 *= rs * par[PAR_SUBLN + lane]; v1 *= rs * par[PAR_SUBLN + 64 + lane];
            const float y0 = bf2f(ATT[orow * DM + hh * 128 + lane]), y1 = bf2f(ATT[orow * DM + hh * 128 + 64 + lane]);
            oracle_flag(ws, wave_sum((v0 - y0) * (v0 - y0) + (v1 - y1) * (v1 - y1)), wave_sum(v0 * v0 + v1 * v1), 3);
        }
    }
}
__global__ void __launch_bounds__(NTHREADS) oracle_kernel(unsigned char* ws, int L) { oracle_check(ws, L); }
#endif

__device__ __forceinline__ void mixer_layer(unsigned char* ws_in, float* out, int L, LAS unsigned char* lds, const XcdBarrier& bar) {
    unsigned char* const ws = ws_in;
#define MIX_VARS() unsigned char* w_ = opq(ws); int tid_ = threadIdx.x; asm volatile("" : "+v"(tid_)); \
    const int tid = tid_, lane = tid & 63, wid = __builtin_amdgcn_readfirstlane(tid >> 6), r32 = lane & 31, hi = lane >> 5; \
    const int G = gridDim.x, gw = blockIdx.x * NWAVES + wid, ngw = G * NWAVES; \
    const int vcu = (G % 8 == 0) ? (int)(blockIdx.x % 8) * (G / 8) + (int)(blockIdx.x / 8) : (int)blockIdx.x;     \
    const float* par = (const float*)w_; bf16* const ATT = (bf16*)(w_ + WS_ATT); bf16* const P = (bf16*)(w_ + WS_BIG); \
    (void)vcu; (void)tid; (void)lane; (void)r32; (void)hi; (void)G; (void)gw; (void)ngw; (void)par; (void)ATT; (void)P
    {
        unsigned char* w_ = opq(ws); const int G = gridDim.x;
        const int Npad = L == 0 ? 1536 : L == 1 ? 3328 : L == 2 ? 1280 : 3072;
        const size_t woff = L == 0 ? W_DSA : L == 1 ? W_FOX : L == 2 ? W_SWA : W_DIFF;
        const float* cos16 = (const float*)(w_ + WS_ROPE); const float* sin16 = cos16 + SEQ * 8; const float* cos8 = sin16 + SEQ * 8; const float* sin8 = cos8 + SEQ * 4;
        pg8::Gemm g{(const bf16*)(w_ + WS_H), (const bf16*)(w_ + WS_W + woff), M, Npad, DM}; pg8::StaticOrder S; S.init(M, Npad, G, (int)blockIdx.x);
        EpiProj E; E.O = (bf16*)(w_ + WS_BIG); E.ldc = Npad; E.q_end = 1024; E.rope_end = L == 0 ? 1024 : L == 1 ? 0 : L == 2 ? 1152 : 2048;
        E.idx_lo = L == 0 ? 1152 : (1 << 30); E.idx_hi = L == 0 ? 1440 : (1 << 30); E.w_lo = L == 0 ? 1440 : -1; E.f_lo = L == 1 ? 3072 : -1;
        E.flog = (float*)(w_ + WS_FLOG); E.cos16 = cos16; E.sin16 = sin16; E.cos8 = cos8; E.sin8 = sin8;
        _Pragma("unroll 1") for (int rep_ = 0, nrep_ = opq_i(1 + RPT_INPROJ); rep_ < nrep_; ++rep_) pg8::gemm_phase<EpiProj, pg8::StaticOrder, true, true>(lds, g, S, E);
    }
    xsync(bar);
    if (L == 0) {
        {
            MIX_VARS(); bf16* const KD = (bf16*)(w_ + WS_KD); bf16* const VD = (bf16*)(w_ + WS_VD);
            const float* cos16 = (const float*)(w_ + WS_ROPE); const float* sin16 = cos16 + SEQ * 8;
            LAS float* Wl = (LAS float*)lds; LAS float* cn = (LAS float*)(lds + 65536 + wid * 2048);
            for (int i = tid; i < 16384; i += NTHREADS) Wl[i] = par[PAR_KVUP + i];
            __syncthreads();
            _Pragma("unroll 1") for (int rep_ = 0, nrep_ = opq_i(1 + RPT_DSAX); rep_ < nrep_; ++rep_)
            for (int t4 = gw; t4 < M / 4; t4 += ngw) {
#pragma unroll
                for (int tk = 0; tk < 4; ++tk) { const size_t row = (size_t)4 * t4 + tk; const float c0 = bf2f(P[row * 1536 + 1024 + lane]), c1 = bf2f(P[row * 1536 + 1088 + lane]);
                    const float ss = wave_sum(c0 * c0 + c1 * c1); const float r = 1.0f / sqrtf(ss * (1.0f / 128.0f) + 1e-6f);
                    cn[tk * 128 + lane] = c0 * r * par[PAR_KVN + lane]; cn[tk * 128 + 64 + lane] = c1 * r * par[PAR_KVN + 64 + lane]; }
                LDS_WAIT(); asm volatile("" ::: "memory");
                float acc[4][2];
#pragma unroll
                for (int tk = 0; tk < 4; ++tk) { acc[tk][0] = 0.f; acc[tk][1] = 0.f; }
#pragma unroll 4
                for (int k = 0; k < 128; ++k) { const float w0 = Wl[k * 128 + lane], w1 = Wl[k * 128 + 64 + lane];
#pragma unroll
                    for (int tk = 0; tk < 4; ++tk) { const float av = cn[tk * 128 + k]; acc[tk][0] += av * w0; acc[tk][1] += av * w1; } }
#pragma unroll
                for (int tk = 0; tk < 4; ++tk) { const size_t row = (size_t)4 * t4 + tk; const int pos = (int)(row & (SEQ - 1));
                    const float oth = __shfl_xor(acc[tk][0], 8); float kk = acc[tk][0];
                    if (lane < 16) { const float cs = cos16[pos * 8 + (lane & 7)], sn = sin16[pos * 8 + (lane & 7)]; kk = lane < 8 ? kk * cs - oth * sn : kk * cs + oth * sn; }
                    KD[row * 64 + lane] = (bf16)f2bf(kk); VD[row * 64 + lane] = (bf16)f2bf(acc[tk][1]); }
                LDS_WAIT(); asm volatile("" ::: "memory");
            }
        }
        {
            MIX_VARS(); float* const SC = (float*)(w_ + WS_SC);
            _Pragma("unroll 1") for (int rep_ = 0, nrep_ = opq_i(1 + RPT_DSAX); rep_ < nrep_; ++rep_)
            for (int u = blockIdx.x; u < 1024; u += G) {
                const int c = u & 255, j = u >> 8, b = c >> 5, s = c & 31, qb = j == 0 ? s : j == 1 ? 63 - s : j == 2 ? 64 + s : 127 - s;
                const size_t row = (size_t)b * SEQ + 32 * qb + r32;
                bf16x8 qf[8][2]; float wq[8];
#pragma unroll
                for (int h = 0; h < 8; ++h) { qf[h][0] = *(const bf16x8*)(P + row * 1536 + 1152 + h * 32 + 8 * hi); qf[h][1] = *(const bf16x8*)(P + row * 1536 + 1152 + h * 32 + 16 + 8 * hi); wq[h] = bf2f(P[row * 1536 + 1440 + h]); }
                float* const srow = SC + sc_rowoff(b, 32 * qb + r32);
                bf16x8 kn0 = qf[0][0], kn1 = qf[0][0];
                if (wid <= qb) { const size_t kr = (size_t)b * SEQ + 32 * wid + r32; kn0 = *(const bf16x8*)(P + kr * 1536 + 1408 + 8 * hi); kn1 = *(const bf16x8*)(P + kr * 1536 + 1408 + 16 + 8 * hi); }
                for (int jt = wid; jt <= qb; jt += NWAVES) {
                    const bf16x8 kf0 = kn0, kf1 = kn1;
                    if (jt + NWAVES <= qb) { const size_t kr = (size_t)b * SEQ + 32 * (jt + NWAVES) + r32; kn0 = *(const bf16x8*)(P + kr * 1536 + 1408 + 8 * hi); kn1 = *(const bf16x8*)(P + kr * 1536 + 1408 + 16 + 8 * hi); }
                    f32x16 sc;
#pragma unroll
                    for (int r = 0; r < 16; ++r) sc[r] = 0.f;
#pragma unroll
                    for (int h = 0; h < 8; ++h) { f32x16 z;
#pragma unroll
                        for (int r = 0; r < 16; ++r) z[r] = 0.f;
                        z = mfma32(kf0, qf[h][0], z); z = mfma32(kf1, qf[h][1], z);
#pragma unroll
                        for (int r = 0; r < 16; ++r) sc[r] += wq[h] * fmaxf(z[r], 0.f);
                        __builtin_amdgcn_sched_barrier(0); }
#pragma unroll
                    for (int g = 0; g < 4; ++g) { f32x4 v; v[0] = sc[4 * g] + 0.0f; v[1] = sc[4 * g + 1] + 0.0f; v[2] = sc[4 * g + 2] + 0.0f; v[3] = sc[4 * g + 3] + 0.0f;
                        *(f32x4*)(srow + 32 * jt + 8 * g + 4 * hi) = v; }
                }
            }
        }
        xsync(bar);
        {
            MIX_VARS(); const float* const SC = (const float*)(w_ + WS_SC); unsigned long long* const BM = (unsigned long long*)(w_ + WS_BM);
            _Pragma("unroll 1") for (int rep_ = 0, nrep_ = opq_i(1 + RPT_DSAX); rep_ < nrep_; ++rep_) {
            f32x4 raw[16];
#define SEL_BT(R_, b_, t_) const int b_ = (R_) >> 12, tt_##t_ = (R_) & 4095, t_ = tt_##t_ < 2048 ? tt_##t_ : 6143 - tt_##t_
            if (gw < M) { SEL_BT(gw, b0, t0); select_load(SC + sc_rowoff(b0, t0), (t0 >> 8) + 1, lane, raw); }
            for (int R = gw; R < M; R += ngw) {
                SEL_BT(R, b, t); const int nj = (t >> 8) + 1;
                f32x4 cur[16];
#pragma unroll
                for (int j = 0; j < 16; ++j) cur[j] = raw[j];
                if (R + ngw < M) { SEL_BT(R + ngw, bn, tn); select_load(SC + sc_rowoff(bn, tn), (tn >> 8) + 1, lane, raw); }
                const unsigned long long myw = select_row(cur, t, nj, lane);
                if (lane < 4 * nj) BM[((size_t)b * SEQ + t) * 64 + lane] = myw;
            }
#undef SEL_BT
            }
        }
        xsync(bar);
        {
            MIX_VARS(); const bf16* const KD = (const bf16*)(w_ + WS_KD); const bf16* const VD = (const bf16*)(w_ + WS_VD); const unsigned long long* const BM = (const unsigned long long*)(w_ + WS_BM);
            _Pragma("unroll 1") for (int rep_ = 0, nrep_ = opq_i(1 + RPT_ATT); rep_ < nrep_; ++rep_)
            for (int u = vcu; u < 1024; u += G) {
                const int c = u & 255, j = u >> 8, bhp = c >> 2, qd = c & 3, pi = (j >> 1) ? 7 - qd : qd, qb = (j & 1) ? 15 - pi : pi, b = bhp >> 3, h = 2 * (bhp & 7), q0 = qb * 256;
                const size_t row = (size_t)b * SEQ + q0 + 32 * wid + r32;
                f32x16 o[2], o2[2]; float l, l2;
                attn_core_h2<64, 3>(lds, P + row * 1536 + h * 64, P + row * 1536 + (h + 1) * 64, KD + (size_t)b * SEQ * 64, 64, VD + (size_t)b * SEQ * 64, 64, nullptr, BM + row * 64, q0, 0, (q0 + 256) / 64, NEGBIG, 0.f, o, l, o2, l2);
                store_o<64>(o, 1.0f / l, ATT + row * DM + h * 64, hi);
                store_o<64>(o2, 1.0f / l2, ATT + row * DM + (h + 1) * 64, hi);
            }
        }
    } else if (L == 1) {
        { MIX_VARS(); float* const FL = (float*)(w_ + WS_FLOG); float* const CT = (float*)(w_ + WS_CUMT);
        for (int task = gw; task < 128; task += ngw) {
            const int b = task >> 4, h = task & 15; const float* fp = FL + ((size_t)b * SEQ + 64 * lane) * 16 + h;
            const float fb = par[PAR_FB + h]; float s = 0.f;
#pragma unroll 8
            for (int i = 0; i < 64; ++i) { const float x = fp[(size_t)i * 16] + fb; s += fminf(x, 0.f) - log1pf(expf(-fabsf(x))); }
            float inc = s;
#pragma unroll
            for (int o_ = 1; o_ < 64; o_ <<= 1) { const float n = __shfl_up(inc, o_); if (lane >= o_) inc += n; }
            float run = inc - s; float* cp = CT + (size_t)task * SEQ + 64 * lane;
#pragma unroll 8
            for (int i = 0; i < 64; ++i) { const float x = fp[(size_t)i * 16] + fb; run += fminf(x, 0.f) - log1pf(expf(-fabsf(x))); cp[i] = -run * LOG2E; }
        } }
        xsync(bar);
        { MIX_VARS(); const float* const CT = (const float*)(w_ + WS_CUMT);
        _Pragma("unroll 1") for (int rep_ = 0, nrep_ = opq_i(1 + RPT_ATT); rep_ < nrep_; ++rep_)
        for (int u = vcu; u < 2048; u += G) {
            const int c = u & 255, j = u >> 8, bh = c >> 1, s = 4 * (c & 1) + (j >> 1), qb = (j & 1) ? 15 - s : s, b = bh >> 4, h = bh & 15, q0 = qb * 256;
            const size_t row = (size_t)b * SEQ + q0 + 32 * wid + r32; const bf16* Pb = P + (size_t)b * SEQ * 3328;
            f32x16 o[2]; float l;
            attn_core<64, 0>(lds, P + row * 3328 + h * 64, Pb + 1024 + h * 64, 3328, Pb + 2048 + h * 64, 3328, CT + (size_t)bh * SEQ, nullptr, q0, 0, (q0 + 256) / 64, NEGBIG, 0.f, o, l);
            store_o<64>(o, 1.0f / l, ATT + row * DM + h * 64, hi);
        } }
    } else if (L == 2) {
        MIX_VARS();
        _Pragma("unroll 1") for (int rep_ = 0, nrep_ = opq_i(1 + RPT_ATT); rep_ < nrep_; ++rep_)
        for (int u = blockIdx.x; u < 2048; u += G) {
            const int b = u >> 8, h = (u >> 4) & 15, qb = u & 15, q0 = qb * 256, gk = h >> 3;
            const size_t row = (size_t)b * SEQ + q0 + 32 * wid + r32; const bf16* Pb = P + (size_t)b * SEQ * 1280;
            f32x16 o[2]; float l;
            attn_core<64, 2>(lds, P + row * 1280 + h * 64, Pb + 1024 + gk * 64, 1280, Pb + 1152 + gk * 64, 1280, nullptr, nullptr, q0, (4 * qb - 2 > 0 ? 4 * qb - 2 : 0), 4 * qb + 4,
                             par[PAR_SINK + h] * LOG2E, 1.0f, o, l);
            store_o<64>(o, 1.0f / l, ATT + row * DM + h * 64, hi);
        }
    } else {
        MIX_VARS();
        const float lambda_init = 0.8f - 0.6f * 0.40656965974059911f;
        const float s01 = wave_sum(par[PAR_LAM + lane] * par[PAR_LAM + 64 + lane]), s23 = wave_sum(par[PAR_LAM + 128 + lane] * par[PAR_LAM + 192 + lane]);
        const float lam = expf(s01) - expf(s23) + lambda_init;
        _Pragma("unroll 1") for (int rep_ = 0, nrep_ = opq_i(1 + RPT_ATT); rep_ < nrep_; ++rep_)
        for (int u = vcu; u < 1024; u += G) {
            const int c = u & 255, j = u >> 8, bhh = c >> 2, qd = c & 3, pi = (j >> 1) ? 7 - qd : qd, qb = (j & 1) ? 15 - pi : pi, b = bhh >> 3, hh = bhh & 7, q0 = qb * 256;
            const size_t row = (size_t)b * SEQ + q0 + 32 * wid + r32; const bf16* Pb = P + (size_t)b * SEQ * 3072;
            f32x16 o1[4]; float l0, l1;
            float* park = (float*)(w_ + WS_PARK) + ((size_t)(blockIdx.x * NWAVES + wid) * 64 + lane) * 64;
            {
                f32x16 o0[4];
                attn_core<128, 1>(lds, P + row * 3072 + (2 * hh) * 64, Pb + 1024 + (2 * hh) * 64, 3072, Pb + 2048 + hh * 128, 3072, nullptr, nullptr, q0, 0, (q0 + 256) / 64, NEGBIG, 0.f, o0, l0);
                const float i0 = 1.0f / l0;
#pragma unroll
                for (int dh = 0; dh < 4; ++dh)
#pragma unroll
                    for (int g = 0; g < 4; ++g) { f32x4 v; v[0] = o0[dh][4 * g] * i0; v[1] = o0[dh][4 * g + 1] * i0; v[2] = o0[dh][4 * g + 2] * i0; v[3] = o0[dh][4 * g + 3] * i0; *(f32x4*)(park + dh * 16 + 4 * g) = v; }
            }
            attn_core<128, 1>(lds, P + row * 3072 + (2 * hh + 1) * 64, Pb + 1024 + (2 * hh + 1) * 64, 3072, Pb + 2048 + hh * 128, 3072, nullptr, nullptr, q0, 0, (q0 + 256) / 64, NEGBIG, 0.f, o1, l1);
            const float i1 = lam / l1; float ss = 0.f;
#pragma unroll
            for (int dh = 0; dh < 4; ++dh)
#pragma unroll
                for (int g = 0; g < 4; ++g) { const f32x4 pv = *(const f32x4*)(park + dh * 16 + 4 * g);
#pragma unroll
                    for (int i = 0; i < 4; ++i) { const float v = pv[i] - o1[dh][4 * g + i] * i1; o1[dh][4 * g + i] = v; ss += v * v; } }
            ss += __shfl_xor(ss, 32);
            const float rs = (1.0f / sqrtf(ss * (1.0f / 128.0f) + 1e-6f)) * (1.0f - lambda_init);
            bf16* orow = ATT + row * DM + hh * 128;
#pragma unroll
            for (int dh = 0; dh < 4; ++dh)
#pragma unroll
                for (int g = 0; g < 4; ++g) { const int d = 32 * dh + 8 * g + 4 * hi; const f32x4 sg = *(const f32x4*)(par + PAR_SUBLN + d);
                    u32x2 w; w.x = pk2(o1[dh][4 * g] * rs * sg[0], o1[dh][4 * g + 1] * rs * sg[1]); w.y = pk2(o1[dh][4 * g + 2] * rs * sg[2], o1[dh][4 * g + 3] * rs * sg[3]);
                    *(u32x2*)(orow + d) = w; }
        }
    }
    xsync(bar);
    {
        unsigned char* w_ = opq(ws);
        pg8::Gemm g{(const bf16*)(w_ + WS_ATT), (const bf16*)(w_ + WS_W + W_OUT + (size_t)L * 1024 * 2048), M, DM, DM}; pg8::StaticOrder S; S.init(M, DM, (int)gridDim.x, (int)blockIdx.x);
        EpiResid<0> E{w_, (const f16*)out, (f16*)out, (L * 72 + 5) | ((L * 3) << 10) | ((12 + L * 3) << 20)}; pg8::gemm_phase<EpiResid<0>, pg8::StaticOrder, EPIRES_ALIGN, true>(lds, g, S, E);
    }
    xsync(bar);
}
struct Args { const float* in[22]; float* out; unsigned char* ws; int s0, s1; };

__device__ __forceinline__ void sincos_d(double a, float& sn, float& cs) {
    const double n = __builtin_rint(a * 0.63661977236758134308);
    const double r = __builtin_fma(-n, 1.57079632679489661923, a) - n * 6.123233995736766e-17;
    const double r2 = r * r;
    double s = -1.0 / 1307674368000.0; s = s * r2 + 1.0 / 6227020800.0; s = s * r2 - 1.0 / 39916800.0; s = s * r2 + 1.0 / 362880.0; s = s * r2 - 1.0 / 5040.0; s = s * r2 + 1.0 / 120.0; s = s * r2 - 1.0 / 6.0; s = s * r2 * r + r;
    double c = 1.0 / 87178291200.0; c = c * r2 - 1.0 / 479001600.0; c = c * r2 + 1.0 / 3628800.0; c = c * r2 - 1.0 / 40320.0; c = c * r2 + 1.0 / 720.0; c = c * r2 - 1.0 / 24.0; c = c * r2 + 0.5; c = 1.0 - c * r2;
    const int q = ((int)n) & 3;
    const double ss = (q == 0) ? s : (q == 1) ? c : (q == 2) ? -s : -c;
    const double cc = (q == 0) ? c : (q == 1) ? -s : (q == 2) ? -c : s;
    sn = (float)ss; cs = (float)cc;
}

#ifndef MIXERS
#define MIXERS 1
#endif
#ifndef STUBMASK
#define STUBMASK 0
#endif

__global__ void __launch_bounds__(NTHREADS, 2) mega(Args a) {
    extern __shared__ __attribute__((aligned(16))) unsigned char lds_raw[];
    LAS unsigned char* lds = (LAS unsigned char*)lds_raw;
    cg::grid_group grid = cg::this_grid();
    const int tid = threadIdx.x, lane = tid & 63, wid = __builtin_amdgcn_readfirstlane(tid >> 6);
    const int G = gridDim.x, gw = blockIdx.x * NWAVES + wid, ngw = G * NWAVES;
    unsigned char* const ws = a.ws;
    if (tid < 2) ((volatile LAS unsigned*)(lds + LDS_MISC))[tid] = 0u;
    __syncthreads();
    const XcdBarrier bar = xcd_barrier_post((unsigned*)(ws + WS_CTLZ), (volatile LAS unsigned*)(lds + LDS_MISC));
    float* const cos16 = (float*)(ws + WS_ROPE); float* const sin16 = cos16 + SEQ * 8; float* const cos8 = sin16 + SEQ * 8; float* const sin8 = cos8 + SEQ * 4;

    if (a.s0 == 0) {
    {
#ifdef ORACLE
        if (blockIdx.x == 0 && tid == 0) *(unsigned*)(ws + 900 * 1024) = 0u;
#endif
        LAS float* scr = (LAS float*)(lds + wid * 16384);
#define CONV_DECODE(it_, d_) do { int r = (it_); \
            if (r < 22528) { const int mi = r / 2816; d_ = ConvDesc{a.in[6] + (size_t)mi * 1024 * 5632, (bf16*)(ws + WS_W + W_FI + mi * W_FI_SZ), 1024, 5632, 5632, r % 2816, true}; break; } r -= 22528; \
            if (r < 11264) { const int mi = r / 1408; d_ = ConvDesc{a.in[7] + (size_t)mi * 2816 * 1024, (bf16*)(ws + WS_W + W_FO + mi * W_FO_SZ), 2816, 1024, 1024, r % 1408, false}; break; } r -= 11264; \
            if (r < 768) { d_ = ConvDesc{a.in[8], (bf16*)(ws + WS_W + W_DSA), 1024, 1448, 1536, r, false}; break; } r -= 768; \
            if (r < 1664) { d_ = ConvDesc{a.in[12], (bf16*)(ws + WS_W + W_FOX), 1024, 3088, 3328, r, false}; break; } r -= 1664; \
            if (r < 640) { d_ = ConvDesc{a.in[15], (bf16*)(ws + WS_W + W_SWA), 1024, 1280, 1280, r, false}; break; } r -= 640; \
            if (r < 1536) { d_ = ConvDesc{a.in[18], (bf16*)(ws + WS_W + W_DIFF), 1024, 3072, 3072, r, false}; break; } r -= 1536; \
            { const int mi = r / 512; const float* src = mi == 0 ? a.in[11] : mi == 1 ? a.in[14] : mi == 2 ? a.in[17] : a.in[21]; \
              d_ = ConvDesc{src, (bf16*)(ws + WS_W + W_OUT + (size_t)mi * 1024 * 2048), 1024, 1024, 1024, r % 512, false}; } } while (0)
        _Pragma("unroll 1") for (int rep_ = 0, nrep_ = opq_i(1 + RPT_P0); rep_ < nrep_; ++rep_) {
            ConvDesc dc{}, dn{}; f32x4 lc[8], ln[8];
            if (gw < 40448) { CONV_DECODE(gw, dn); conv_load(dn, lane, ln); }
            for (int it = gw; it < 40448; it += ngw) {
                dc = dn;
#pragma unroll
                for (int i = 0; i < 8; ++i) lc[i] = ln[i];
                if (it + ngw < 40448) { CONV_DECODE(it + ngw, dn); conv_load(dn, lane, ln); }
                conv_store(dc, scr, lane, lc);
            }
        }
#undef CONV_DECODE
        for (int idx = blockIdx.x * NTHREADS + tid; idx < SEQ * 12; idx += G * NTHREADS) {
            const float inv16[8] = {1.0f, 0.1939227432012558f, 0.03760603070259094f, 0.007292664609849453f, 0.0014142135623842478f, 0.00027424818836152554f, 5.318296098266728e-05f, 1.0313386155758053e-05f};
            float sn, cs;
            if (idx < SEQ * 8) { const int pos = idx >> 3, i = idx & 7; const float inv = i == 0 ? inv16[0] : i == 1 ? inv16[1] : i == 2 ? inv16[2] : i == 3 ? inv16[3] : i == 4 ? inv16[4] : i == 5 ? inv16[5] : i == 6 ? inv16[6] : inv16[7];
                const float ang = (float)pos * inv; sincos_d((double)ang, sn, cs); cos16[idx] = cs; sin16[idx] = sn; }
            else { const int j = idx - SEQ * 8, pos = j >> 2, i = j & 3; const float inv = i == 0 ? inv16[0] : i == 1 ? inv16[2] : i == 2 ? inv16[4] : inv16[6];
                const float ang = (float)pos * inv; sincos_d((double)ang, sn, cs); cos8[j] = cs; sin8[j] = sn; }
        }
        {
            float* par = (float*)ws;
            for (int i = blockIdx.x * NTHREADS + tid; i < PAR_N; i += G * NTHREADS) {
                float v;
                if (i < 12288) v = a.in[2][i]; else if (i < 24576) v = a.in[3][i - 12288]; else if (i < 24704) v = a.in[9][i - 24576]; else if (i < 41088) v = a.in[10][i - 24704];
                else if (i < 41104) v = a.in[13][i - 41088]; else if (i < 41120) v = a.in[16][i - 41104]; else if (i < 41376) v = a.in[19][i - 41120]; else if (i < 41504) v = a.in[20][i - 41376]; else v = (i >= PAR_ONE && i < PAR_ZERO) ? 1.0f : 0.0f;
                par[i] = v; }
        }
        __syncthreads();
        LAS float* cond = (LAS float*)lds;
        for (int i = tid; i < NBATCH * DM; i += NTHREADS) { const float c = a.in[1][i]; cond[i] = c / (1.0f + expf(-c)); }
        __syncthreads();
        float* modp = (float*)(ws + WS_BIG);
        for (int task = gw; task < 4608; task += ngw) {
            const int kc = task / 288, cgp = task % 288, layer = cgp / 72, col = (cgp % 72) * 128 + (lane & 31) * 4, kpar = lane >> 5;
            f32x4 acc[8];
#pragma unroll
            for (int b = 0; b < 8; ++b) acc[b] = (f32x4){0.f, 0.f, 0.f, 0.f};
            const float* wp = a.in[4] + ((size_t)layer * 1024 + kc * 64 + kpar) * MODW + col;
#pragma unroll 4
            for (int kk = 0; kk < 32; ++kk) { const f32x4 w4 = *(const f32x4*)(wp + (size_t)(2 * kk) * MODW); const int k = kc * 64 + 2 * kk + kpar;
#pragma unroll
                for (int b = 0; b < 8; ++b) acc[b] += w4 * cond[b * 1024 + k]; }
#pragma unroll
            for (int b = 0; b < 8; ++b)
#pragma unroll
                for (int i = 0; i < 4; ++i) acc[b][i] += __shfl_xor(acc[b][i], 32);
            if (kpar == 0) {
#pragma unroll
                for (int b = 0; b < 8; ++b) *(f32x4*)(modp + (size_t)kc * 294912 + ((size_t)layer * 8 + b) * MODW + col) = acc[b]; }
        }
    }
    gsync(grid);
    {
        const float* modp = (const float*)(ws + WS_BIG);
        for (int i = blockIdx.x * NTHREADS + tid; i < 294912; i += G * NTHREADS) {
            const int layer = i / 73728, col = i % MODW; float s = a.in[5][layer * MODW + col];
#pragma unroll
            for (int kc = 0; kc < 16; ++kc) s += modp[(size_t)kc * 294912 + i];
            ((float*)(ws + WS_MOD))[i] = s; }
    }
    xsync(bar);
    { unsigned char* w = opq(ws); const float* md = (const float*)(w + WS_MOD); ln_rows<false>(a.in[0], (f16*)a.out, nullptr, (bf16*)(w + WS_H), nullptr, nullptr, md + 1024, md, false, true, 1.0f, (float*)(w + WS_STATS), false); }
    xsync(bar);
    }

#pragma unroll 1
    for (int L = 0; L < NLAYER; ++L) {
#pragma unroll 1
        for (int sub = 0; sub < 3; ++sub) {
            if (L * 3 + sub < a.s0 || L * 3 + sub >= a.s1) continue;
            float pre = 1.0f;
            if (sub != 1) {
                const int fi = L * 2 + (sub >> 1);
                { unsigned char* w = opq(ws);
                  pg8::Gemm g{(const bf16*)(w + WS_H), (const bf16*)(w + WS_W + W_FI + fi * W_FI_SZ), M, 2 * FF, DM}; pg8::StaticOrder S; S.init(M, 2 * FF, (int)gridDim.x, (int)blockIdx.x);
                  EpiSwiGLU E{(bf16*)(w + WS_BIG), FF}; _Pragma("unroll 1") for (int rep_ = 0, nrep_ = opq_i(1 + RPT_FFNUP); rep_ < nrep_; ++rep_) pg8::gemm_phase<EpiSwiGLU, pg8::StaticOrder, FFNUP_ALIGN, true>(lds, g, S, E); }
                xsync(bar);
                { unsigned char* w = opq(ws); const f16* xres = (const f16*)a.out; f16* vout = (L == NLAYER - 1 && sub == 2) ? (f16*)(w + WS_PARK) : (f16*)a.out;
                  pg8::Gemm g{(const bf16*)(w + WS_BIG), (const bf16*)(w + WS_W + W_FO + fi * W_FO_SZ), M, DM, FF}; pg8::StaticOrder S; S.init(M, DM, (int)gridDim.x, (int)blockIdx.x);
                  const bool first = (L == 0 && sub == 0); const int pidx = L * 3 + sub - 1;
                  const int code = (L * 72 + 3 * sub + 2) | ((first ? PAR_ONE / 1024 : pidx) << 10) | ((first ? PAR_ZERO / 1024 : 12 + pidx) << 20);
#if RPT_FFNDN
                  { EpiResid<1> Ed{w, xres, (f16*)(w + WS_PARK + 64 * MiB), code}; pg8::gemm_phase<EpiResid<1>, pg8::StaticOrder, EPIRES_ALIGN, true>(lds, g, S, Ed); xsync(bar); }
#endif
                  EpiResid<1> E{w, xres, vout, code}; pg8::gemm_phase<EpiResid<1>, pg8::StaticOrder, EPIRES_ALIGN, true>(lds, g, S, E); }
                xsync(bar);
            } else {
#if MIXERS
                if ((STUBMASK >> L) & 1) pre = ALPHA; else mixer_layer(ws, a.out, L, lds, bar);
#else
                pre = ALPHA;
#endif
            }
            { unsigned char* w = opq(ws); const float* modL = (const float*)(w + WS_MOD) + (size_t)L * 8 * MODW;
              const bool write_h = !(L == NLAYER - 1 && sub == 2);
              const float* nsc = sub < 2 ? modL + (3 * (sub + 1) + 1) * 1024 : modL + 8 * MODW + 1024;
              const float* nsh = sub < 2 ? modL + (3 * (sub + 1)) * 1024 : modL + 8 * MODW;
              const bool last = (L == NLAYER - 1 && sub == 2);
              ln_rows<true>(last ? (const void*)(w + WS_PARK) : (const void*)a.out, nullptr, a.out, (bf16*)(w + WS_H), (const float*)w + PAR_LNG + (L * 3 + sub) * DM, (const float*)w + PAR_LNB + (L * 3 + sub) * DM, nsc, nsh, true, write_h, pre, (float*)(w + WS_STATS), !write_h || (MIXERS == 0)); }
            xsync(bar);
        }
    }
#ifdef ORACLE
    if (a.s1 == 12 && blockIdx.x == 0 && threadIdx.x == 0) { const unsigned fl = *(volatile unsigned*)(ws + 900 * 1024);
        for (int bit = 0; bit < 5; ++bit) if ((fl >> bit) & 1u) for (int e = 0; e < (1 << bit); ++e) a.out[(1 << bit) - 1 + e] += 1830.0f; }
#endif
}

extern "C" void kernel_launch(void* const* d_in, const int* in_sizes, int n_in, void* d_out, int out_size, void* d_ws, size_t ws_size, hipStream_t stream) {
    static int grid = 0;
    if (grid == 0) {
        if (n_in != 22 || out_size != M * DM || ws_size < WS_END) { fprintf(stderr, "kernel_launch: unexpected shapes (n_in %d out %d ws %zu)\n", n_in, out_size, ws_size); grid = -1; return; }
        int dev = 0, cus = 0, per_cu = 0;
        hipGetDevice(&dev); hipDeviceGetAttribute(&cus, hipDeviceAttributeMultiprocessorCount, dev);
        if (hipFuncSetAttribute((const void*)mega, hipFuncAttributeMaxDynamicSharedMemorySize, LDS_BYTES) != hipSuccess) fprintf(stderr, "kernel_launch: hipFuncSetAttribute failed\n");
        if (hipOccupancyMaxActiveBlocksPerMultiprocessor(&per_cu, (const void*)mega, NTHREADS, LDS_BYTES) != hipSuccess || per_cu < 1) per_cu = 1;
        (void)hipGetLastError();
        grid = cus * per_cu; if (grid > 256) grid = 256;
    }
    if (grid < 0) return;
    if (hipMemsetAsync((char*)d_ws + WS_CTLZ, 0, CTLZ_BYTES, stream) != hipSuccess) { fprintf(stderr, "kernel_launch: hipMemsetAsync failed\n"); return; }
    Args a{};
    for (int i = 0; i < 22; ++i) a.in[i] = (const float*)d_in[i];
    a.out = (float*)d_out; a.ws = (unsigned char*)d_ws;
#ifdef ORACLE
    const int cuts[6] = {0, 2, 5, 8, 11, 12}; hipError_t e = hipSuccess;
    for (int li = 0; li < 5; ++li) { a.s0 = cuts[li]; a.s1 = cuts[li + 1]; void* args[] = {&a};
        e = hipLaunchCooperativeKernel((const void*)mega, dim3(grid), dim3(NTHREADS), args, LDS_BYTES, stream);
        if (li < 4) hipLaunchKernelGGL(oracle_kernel, dim3(4), dim3(NTHREADS), 0, stream, (unsigned char*)d_ws, li); }
#else
    a.s0 = 0; a.s1 = 12;
    void* args[] = {&a};
    hipError_t e = hipLaunchCooperativeKernel((const void*)mega, dim3(grid), dim3(NTHREADS), args, LDS_BYTES, stream);
#endif
    if (e != hipSuccess) fprintf(stderr, "cooperative launch failed: %s (grid %d)\n", hipGetErrorString(e), grid);
}
```

```cpp
#include <hip/hip_runtime.h>
#include <hip/hip_cooperative_groups.h>
#include <cstdio>
#include <cstdint>
namespace cg = cooperative_groups;
namespace pg8 {
#define PG8_LAS __attribute__((address_space(3)))
typedef unsigned short bf16_t;
typedef short bf16x8 __attribute__((ext_vector_type(8)));
typedef float f32x4 __attribute__((ext_vector_type(4)));
typedef unsigned u32x4 __attribute__((ext_vector_type(4)));
constexpr int BM = 256, BK = 64, HALF = 128, HTB = HALF * BK * 2  , STAGE_BYTES = 8 * HTB, NXCD = 8, WGM = 8;

__host__ __device__ __forceinline__ int lds_byte(int r, int c) { const int st = (r >> 4) * 2 + (c >> 5), rr = r & 15, cc = c & 31, ob = rr * 64 + cc * 2; return st * 1024 + (ob ^ (((ob >> 9) & 1) << 5)); }
__host__ __device__ __forceinline__ void stage_rc(int b, int& R, int& C) { const int st = b / 1024, sb = b % 1024, swz = sb ^ (((sb >> 9) & 1) << 5); R = (st >> 1) * 16 + swz / 64; C = (st & 1) * 32 + (swz % 64) / 2; }
__host__ __device__ __forceinline__ int perm32(int rho) { const int n = rho >> 4, i = rho & 15; return 8 * (i >> 2) + 4 * n + (i & 3); }

struct Unit { int pm, pn; };
struct Gemm { const bf16_t* A; const bf16_t* Bt; int M, N, K; };

struct StaticOrder {
    int nM, nN, nwg, G, c;
    __host__ __device__ void init(int M, int N, int G_, int c_) { nM = M / BM; nN = N / BM; nwg = nM * nN; G = G_; c = c_; }
    __host__ __device__ bool next(int i, Unit& u) const {
        const long L = (long)i * G + c; if (L >= nwg) return false;
        int wgid = (int)L; { const int q = nwg / NXCD, r = nwg % NXCD, xcd = wgid % NXCD, off = wgid / NXCD; wgid = (xcd < r ? xcd * (q + 1) : r * (q + 1) + (xcd - r) * q) + off; }
        const int nig = WGM * nN, gid = wgid / nig, fm = gid * WGM, gsz = (nM - fm) < WGM ? (nM - fm) : WGM;
        u.pm = fm + ((wgid % nig) % gsz); u.pn = (wgid % nig) / gsz; return true;
    }
    __device__ __forceinline__ void a_ready(const Unit&) const {}
    __device__ __forceinline__ void done(const Unit&) const {}
};

__device__ __forceinline__ unsigned cvt_pk_bf16(float lo, float hi) { unsigned r; asm volatile("v_cvt_pk_bf16_f32 %0, %1, %2" : "=v"(r) : "v"(lo), "v"(hi)); return r; }
typedef float f32x2 __attribute__((ext_vector_type(2)));
template <class Epi, class Sched, bool ALIGN_EPI = false, bool SP2 = false>
__device__ __forceinline__ void gemm_phase(PG8_LAS unsigned char* lds, const Gemm g, const Sched& S, const Epi& E) {
    int tid_ = threadIdx.x; asm volatile("" : "+v"(tid_));
    const int tid = tid_, wid = __builtin_amdgcn_readfirstlane(tid >> 6), lane = tid & 63, wr = wid >> 2, wc = wid & 3, fr = lane & 15, fq = lane >> 4;
    const int K = g.K, nt = K / BK;
    unsigned voffA[2], voffB[2];
#pragma unroll
    for (int i = 0; i < 2; ++i) { int R, C; stage_rc(tid * 16 + i * 8192, R, C); const int Rb = Epi::PERM ? ((R & ~31) + perm32(R & 31)) : R;
        voffA[i] = (unsigned)(R * K + C) * 2u; voffB[i] = (unsigned)(Rb * K + C) * 2u; }
    const size_t kstep = (size_t)(BK * 2);
    const size_t hstep = (size_t)HALF * K * 2;
    const size_t tstep = 2 * hstep;
    const unsigned ldsw = (unsigned)wid * 1024u;
    const int aoff = lds_byte(wr * 64 + fr, fq * 8), boff = lds_byte(wc * 32 + fr, fq * 8);
#define PG8_SA(b, h) (((b) * 2 + (h)) * HTB)
#define PG8_SB(b, h) ((4 + (b) * 2 + (h)) * HTB)
#define PG8_STAGE(bufoff, gbase, voff) do { _Pragma("unroll") for (int _i = 0; _i < 2; ++_i) \
        __builtin_amdgcn_global_load_lds((const unsigned*)((const char*)(gbase) + (voff)[_i]), (PG8_LAS unsigned*)(lds + (bufoff) + ldsw + _i * 8192), 16, 0, 0); } while (0)
#define PG8_LDA(dst, b, h) do { _Pragma("unroll") for (int m = 0; m < 4; ++m) _Pragma("unroll") for (int k = 0; k < 2; ++k) dst[m][k] = *(const PG8_LAS bf16x8*)(lds + PG8_SA(b, h) + aoff + m * 2048 + k * 1024); } while (0)
#define PG8_LDB(dst, b, h) do { _Pragma("unroll") for (int n = 0; n < 2; ++n) _Pragma("unroll") for (int k = 0; k < 2; ++k) dst[n][k] = *(const PG8_LAS bf16x8*)(lds + PG8_SB(b, h) + boff + n * 2048 + k * 1024); } while (0)
#define PG8_MMA(ai, bj, At, Bt) do { __builtin_amdgcn_s_setprio(1); _Pragma("unroll") for (int m = 0; m < 4; ++m) _Pragma("unroll") for (int n = 0; n < 2; ++n) _Pragma("unroll") for (int k = 0; k < 2; ++k) \
        acc[ai][bj][m][n] = __builtin_amdgcn_mfma_f32_16x16x32_bf16(Bt[n][k], At[m][k], acc[ai][bj][m][n], 0, 0, 0); __builtin_amdgcn_s_setprio(0); } while (0)
#define PG8_WAIT_V(n) asm volatile("s_waitcnt vmcnt(" #n ")" ::: "memory")
#define PG8_WAIT_L(n) asm volatile("s_waitcnt lgkmcnt(" #n ")" ::: "memory")
#define PG8_BAR __builtin_amdgcn_s_barrier()
#define PG8_SCHED __builtin_amdgcn_sched_barrier(0)
    Unit cur, nxt; int ui = 0;
    if (!S.next(0, cur)) return;
    f32x4 acc[2][2][4][2];
#pragma unroll
    for (int a = 0; a < 2; ++a)
#pragma unroll
        for (int b = 0; b < 2; ++b)
#pragma unroll
            for (int m = 0; m < 4; ++m)
#pragma unroll
                for (int n = 0; n < 2; ++n) acc[a][b][m][n] = (f32x4){0.f, 0.f, 0.f, 0.f};
    bf16x8 At[4][2], B0[2][2], B1[2][2];
    const char* cA = (const char*)g.A + (size_t)cur.pm * tstep; const char* cB = (const char*)g.Bt + (size_t)cur.pn * tstep;
    S.a_ready(cur);
    if constexpr (SP2) {
        PG8_STAGE(PG8_SB(0, 0), cB, voffB); PG8_STAGE(PG8_SB(0, 1), cB + hstep, voffB); PG8_STAGE(PG8_SA(0, 0), cA, voffA); PG8_STAGE(PG8_SA(0, 1), cA + hstep, voffA);
        if (wr == 1) PG8_BAR;
        PG8_WAIT_V(2); PG8_BAR;
        PG8_STAGE(PG8_SB(1, 0), cB + kstep, voffB); PG8_STAGE(PG8_SA(1, 0), cA + kstep, voffA); PG8_STAGE(PG8_SB(1, 1), cB + hstep + kstep, voffB);
        PG8_WAIT_V(6); PG8_BAR;
    } else {
        PG8_STAGE(PG8_SB(0, 0), cB, voffB); PG8_STAGE(PG8_SA(0, 0), cA, voffA); PG8_STAGE(PG8_SB(0, 1), cB + hstep, voffB); PG8_STAGE(PG8_SA(0, 1), cA + hstep, voffA);
        if (wr == 1) PG8_BAR;
        PG8_WAIT_V(4); PG8_BAR;
        PG8_STAGE(PG8_SB(1, 0), cB + kstep, voffB); PG8_STAGE(PG8_SA(1, 0), cA + kstep, voffA); PG8_STAGE(PG8_SB(1, 1), cB + hstep + kstep, voffB);
        PG8_WAIT_V(6); PG8_BAR;
    }
    for (;;) {
        const bool has_next = S.next(ui + 1, nxt);
        const char* nA = has_next ? (const char*)g.A + (size_t)nxt.pm * tstep : cA; const char* nB = has_next ? (const char*)g.Bt + (size_t)nxt.pn * tstep : cB;
        for (int t = 0; t < nt; t += 2) {
            const bool last = (t == nt - 2);
            const char* a1 = cA + (size_t)(t + 1) * kstep;
            const char* a2 = last ? nA : cA + (size_t)(t + 2) * kstep; const char* b2 = last ? nB : cB + (size_t)(t + 2) * kstep;
            const char* a3 = a2 + kstep; const char* b3 = b2 + kstep;
            if (last && has_next) S.a_ready(nxt);
            if constexpr (SP2) {
            PG8_LDB(B0, 0, 0); PG8_LDB(B1, 0, 1); PG8_SCHED; PG8_LDA(At, 0, 0); PG8_STAGE(PG8_SA(1, 1), a1 + hstep, voffA);
            PG8_WAIT_V(8); PG8_WAIT_L(0); PG8_BAR; PG8_MMA(0, 0, At, B0); PG8_MMA(0, 1, At, B1); PG8_BAR; PG8_SCHED;
            PG8_LDA(At, 0, 1); PG8_STAGE(PG8_SB(0, 0), b2, voffB); PG8_STAGE(PG8_SB(0, 1), b2 + hstep, voffB); PG8_STAGE(PG8_SA(0, 0), a2, voffA);
            PG8_WAIT_V(8); PG8_WAIT_L(0); PG8_BAR; PG8_MMA(1, 0, At, B0); PG8_MMA(1, 1, At, B1); PG8_BAR; PG8_SCHED;
            PG8_LDB(B0, 1, 0); PG8_LDB(B1, 1, 1); PG8_SCHED; PG8_LDA(At, 1, 0); PG8_STAGE(PG8_SA(0, 1), a2 + hstep, voffA);
            PG8_WAIT_V(8); PG8_WAIT_L(0); PG8_BAR; PG8_MMA(0, 0, At, B0); PG8_MMA(0, 1, At, B1); PG8_BAR; PG8_SCHED;
            PG8_LDA(At, 1, 1); PG8_STAGE(PG8_SB(1, 0), b3, voffB); PG8_STAGE(PG8_SB(1, 1), b3 + hstep, voffB); PG8_STAGE(PG8_SA(1, 0), a3, voffA);
            PG8_WAIT_V(8); PG8_WAIT_L(0); PG8_BAR; PG8_MMA(1, 0, At, B0); PG8_MMA(1, 1, At, B1); PG8_BAR; PG8_SCHED;
            } else {
            PG8_LDB(B0, 0, 0); PG8_SCHED; PG8_LDA(At, 0, 0); PG8_STAGE(PG8_SA(1, 1), a1 + hstep, voffA);
            PG8_WAIT_L(8); PG8_BAR; PG8_WAIT_L(0); PG8_MMA(0, 0, At, B0); PG8_BAR; PG8_SCHED;
            PG8_LDB(B1, 0, 1); PG8_STAGE(PG8_SB(0, 0), b2, voffB);
            PG8_BAR; PG8_WAIT_L(0); PG8_MMA(0, 1, At, B1); PG8_BAR;
            PG8_LDA(At, 0, 1); PG8_STAGE(PG8_SA(0, 0), a2, voffA);
            PG8_BAR; PG8_WAIT_L(0); PG8_MMA(1, 0, At, B0); PG8_BAR; PG8_SCHED;
            PG8_STAGE(PG8_SB(0, 1), b2 + hstep, voffB);
            PG8_WAIT_V(6); PG8_BAR; PG8_MMA(1, 1, At, B1); PG8_BAR;
            PG8_LDB(B0, 1, 0); PG8_SCHED; PG8_LDA(At, 1, 0); PG8_STAGE(PG8_SA(0, 1), a2 + hstep, voffA);
            PG8_WAIT_L(8); PG8_BAR; PG8_WAIT_L(0); PG8_MMA(0, 0, At, B0); PG8_BAR; PG8_SCHED;
            PG8_LDB(B1, 1, 1); PG8_STAGE(PG8_SB(1, 0), b3, voffB);
            PG8_BAR; PG8_WAIT_L(0); PG8_MMA(0, 1, At, B1); PG8_BAR;
            PG8_LDA(At, 1, 1); PG8_STAGE(PG8_SA(1, 0), a3, voffA);
            PG8_BAR; PG8_WAIT_L(0); PG8_MMA(1, 0, At, B0); PG8_BAR; PG8_SCHED;
            PG8_STAGE(PG8_SB(1, 1), b3 + hstep, voffB);
            PG8_WAIT_V(6); PG8_BAR; PG8_MMA(1, 1, At, B1); PG8_BAR;
            }
        }
        if constexpr (ALIGN_EPI) { if (wr == 0) PG8_BAR; }
        if constexpr (!Epi::AFTER_DRAIN) { E(acc, cur, wr, wc, fr, fq); S.done(cur); }
        if (!has_next) break;
#pragma unroll
        for (int a = 0; a < 2; ++a)
#pragma unroll
            for (int b = 0; b < 2; ++b)
#pragma unroll
                for (int m = 0; m < 4; ++m)
#pragma unroll
                    for (int n = 0; n < 2; ++n) acc[a][b][m][n] = (f32x4){0.f, 0.f, 0.f, 0.f};
        cur = nxt; cA = nA; cB = nB; ++ui;
        if constexpr (ALIGN_EPI) { if (wr == 1) PG8_BAR; }
    }
    PG8_WAIT_V(0);
    if constexpr (!ALIGN_EPI) { if (wr == 0) PG8_BAR; }
    PG8_BAR;
    if constexpr (Epi::AFTER_DRAIN) { E.fused(acc, cur, wr, wc, fr, fq, lds, wid, lane); S.done(cur); }
#undef PG8_SA
#undef PG8_SB
#undef PG8_STAGE
#undef PG8_LDA
#undef PG8_LDB
#undef PG8_MMA
#undef PG8_WAIT_V
#undef PG8_WAIT_L
#undef PG8_BAR
#undef PG8_SCHED
}
}
#ifndef RPT_ATT
#define RPT_ATT 0
#endif
#ifndef RPT_DSAX
#define RPT_DSAX 0
#endif
#ifndef RPT_INPROJ
#define RPT_INPROJ 0
#endif
#ifndef RPT_FFNUP
#define RPT_FFNUP 0
#endif
#ifndef RPT_P0
#define RPT_P0 0
#endif
#ifndef RPT_FFNDN
#define RPT_FFNDN 0
#endif
#ifndef RPT_LN
#define RPT_LN 0
#endif
#ifndef RPT_SYNC
#define RPT_SYNC 0
#endif
#ifndef FFNUP_ALIGN
#define FFNUP_ALIGN true
#endif
#ifndef EPIRES_ALIGN
#define EPIRES_ALIGN true
#endif
#define LAS __attribute__((address_space(3)))
typedef unsigned short bf16;
typedef short bf16x8 __attribute__((ext_vector_type(8)));
typedef float f32x4 __attribute__((ext_vector_type(4)));
typedef float f32x16 __attribute__((ext_vector_type(16)));
typedef unsigned u32x4 __attribute__((ext_vector_type(4)));
typedef unsigned u32x2 __attribute__((ext_vector_type(2)));
typedef _Float16 f16;
typedef _Float16 f16x4 __attribute__((ext_vector_type(4)));
constexpr int M = 32768, SEQ = 4096, DM = 1024, FF = 2816, NBATCH = 8, NLAYER = 4;
constexpr int NTHREADS = 512, NWAVES = 8;
constexpr float ALPHA = 1.6817928305074290f;
constexpr float LOG2E = 1.4426950408889634f;
constexpr float C2 = 0.125f * 1.4426950408889634f;
constexpr float LN_EPS = 1e-5f;
constexpr float NEGBIG = -1e30f;
constexpr int MODW = 9 * DM;

constexpr size_t MiB = 1u << 20;
constexpr size_t WS_MOD = 1 * MiB;
constexpr size_t WS_ROPE = 3 * MiB;
constexpr size_t WS_FLOG = 4 * MiB;
constexpr size_t WS_CUMT = 6 * MiB;
constexpr size_t WS_KD = 8 * MiB, WS_VD = 12 * MiB;
constexpr size_t WS_BM = 16 * MiB;
constexpr size_t WS_W = 32 * MiB;
constexpr size_t WS_H = 200 * MiB;
constexpr size_t WS_ATT = 264 * MiB;
constexpr size_t WS_BIG = 328 * MiB;
constexpr size_t WS_SC = 424 * MiB;
constexpr size_t WS_PARK = 560 * MiB;
constexpr size_t WS_END = 696 * MiB;
constexpr size_t W_FI = 0, W_FI_SZ = (size_t)5632 * 1024 * 2;
constexpr size_t W_FO = 8 * W_FI_SZ, W_FO_SZ = (size_t)1024 * 2816 * 2;
constexpr size_t W_DSA = W_FO + 8 * W_FO_SZ;
constexpr size_t W_FOX = W_DSA + (size_t)1536 * 2048;
constexpr size_t W_SWA = W_FOX + (size_t)3328 * 2048;
constexpr size_t W_DIFF = W_SWA + (size_t)1280 * 2048;
constexpr size_t W_OUT = W_DIFF + (size_t)3072 * 2048;
static_assert(W_OUT + 4 * (size_t)1024 * 2048 <= 168 * MiB, "weights region");
constexpr int LDS_BYTES = 144 * 1024;
constexpr int LDS_MISC = 132 * 1024;
constexpr size_t WS_STATS = 768 * 1024;
constexpr size_t WS_CTLZ = 512 * 1024, CTLZ_BYTES = 256 * 1024;
constexpr int PAR_LNG = 0, PAR_LNB = 12288, PAR_KVN = 24576, PAR_KVUP = 24704, PAR_FB = 41088, PAR_SINK = 41104, PAR_LAM = 41120, PAR_SUBLN = 41376, PAR_ONE = 43008, PAR_ZERO = 44032, PAR_N = 45056;

__device__ __forceinline__ unsigned f2bf(float f) { unsigned u = __builtin_bit_cast(unsigned, f); return (u + 0x7fffu + ((u >> 16) & 1u)) >> 16; }
__device__ __forceinline__ unsigned pk2(float lo, float hi) { return pg8::cvt_pk_bf16(lo, hi); }
__device__ __forceinline__ float bf2f(unsigned short b) { return __builtin_bit_cast(float, (unsigned)b << 16); }
__device__ __forceinline__ float fast_exp2(float x) { return __builtin_amdgcn_exp2f(x); }
__device__ __forceinline__ float fast_rcp(float x) { return __builtin_amdgcn_rcpf(x); }
#define LDS_WAIT() asm volatile("s_waitcnt lgkmcnt(0)" ::: "memory")
__device__ __forceinline__ unsigned char* opq(unsigned char* p) { asm volatile("" : "+s"(p)); return p; }

#define XB_TMO      128
#define XB_XCNT(j)  (256  + 64 * (j))
#define XB_XSUB(j)  (1280 + 64 * (j))
#define XB_XGEN(j)  (2304 + 64 * (j))
#define XB_TOP      3328
#define XB_TOPGEN   3392
#define XCD_BAR_WORDS 3456
#define XB_SPIN_CAP (1u << 18)

__device__ __forceinline__ unsigned xb_ld(unsigned* p)              { return __hip_atomic_load(p, __ATOMIC_RELAXED, __HIP_MEMORY_SCOPE_AGENT); }
__device__ __forceinline__ unsigned xb_add(unsigned* p, unsigned v) { return __hip_atomic_fetch_add(p, v, __ATOMIC_RELAXED, __HIP_MEMORY_SCOPE_AGENT); }
__device__ __forceinline__ unsigned xb_xcc_id() { return (unsigned)__builtin_amdgcn_s_getreg((3 << 11) | 20) & 0xFu; }
#define XB_SPIN(cond, bar) do { unsigned _sp = 0; while (cond) { __builtin_amdgcn_s_sleep(1); \
    if ((++_sp & 255u) == 0u) { if (xb_ld(&(bar)[XB_TMO])) break; if (_sp > XB_SPIN_CAP) { atomicAdd(&(bar)[XB_TMO], 1u); break; } } } } while (0)

struct XcdBarrier {
    unsigned* bar; unsigned x;
    volatile LAS unsigned* st;
};

__device__ __forceinline__ XcdBarrier xcd_barrier_post(unsigned* bar, volatile LAS unsigned* st) {
    XcdBarrier b; b.bar = bar; b.x = xb_xcc_id(); b.st = st;
    if (threadIdx.x == 0) (void)xb_add(&bar[XB_XCNT(b.x)], 1u);
    return b;
}
__device__ __forceinline__ void xcd_barrier_complete(unsigned* bar, unsigned x, unsigned& nloc, unsigned& nx) {
    const unsigned G = gridDim.x * gridDim.y * gridDim.z;
    unsigned sum, cnt, mine, sp = 0u;
    for (;;) {
        sum = 0u; cnt = 0u; mine = 0u;
#pragma unroll
        for (unsigned j = 0; j < 16; ++j) { const unsigned c = xb_ld(&bar[XB_XCNT(j)]); sum += c; cnt += (c > 0u) ? 1u : 0u; mine = (j == x) ? c : mine; }
        if (sum == G) break;
        __builtin_amdgcn_s_sleep(1);
        if ((++sp & 255u) == 0u) { if (xb_ld(&bar[XB_TMO])) break; if (sp > XB_SPIN_CAP) { atomicAdd(&bar[XB_TMO], 1u); break; } }
    }
    nloc = mine > 0u ? mine : 1u; nx = cnt > 0u ? cnt : 1u;
}

__device__ __forceinline__ void xcd_barrier(const XcdBarrier& b) {
    asm volatile("s_waitcnt vmcnt(0)" ::: "memory");
    __syncthreads();
    if (threadIdx.x == 0) {
        unsigned* bar = b.bar;
        __builtin_amdgcn_s_waitcnt(0);
        unsigned nloc = b.st[0], nx = b.st[1];
        if (nloc == 0u) { xcd_barrier_complete(bar, b.x, nloc, nx); b.st[0] = nloc; b.st[1] = nx; }
        const unsigned old = xb_add(&bar[XB_XSUB(b.x)], 1u);
        const unsigned gen = old / nloc;
        if (old + 1u == (gen + 1u) * nloc) {
            __builtin_amdgcn_fence(__ATOMIC_RELEASE, "agent");
            asm volatile("s_waitcnt vmcnt(0)" ::: "memory");
            const unsigned og = xb_add(&bar[XB_TOP], 1u);
            const unsigned tg = og / nx;
            if (og + 1u == (tg + 1u) * nx) xb_add(&bar[XB_TOPGEN], 1u);
            else XB_SPIN(xb_ld(&bar[XB_TOPGEN]) == tg, bar);
            __builtin_amdgcn_fence(__ATOMIC_ACQUIRE, "agent");
            xb_add(&bar[XB_XGEN(b.x)], 1u);
            asm volatile("s_waitcnt vmcnt(0)" ::: "memory");
        } else {
            XB_SPIN(xb_ld(&bar[XB_XGEN(b.x)]) == gen, bar);
            __builtin_amdgcn_fence(__ATOMIC_ACQUIRE, "agent");
            asm volatile("s_waitcnt vmcnt(0)" ::: "memory");
        }
    }
    __syncthreads();
}

__device__ __forceinline__ void xsync(const XcdBarrier& b) { xcd_barrier(b); }
__device__ __forceinline__ int opq_i(int v) { asm volatile("" : "+s"(v)); return v; }
__device__ __forceinline__ void gsync(cg::grid_group& g) {
    asm volatile("s_waitcnt vmcnt(0) lgkmcnt(0)" ::: "memory");
    g.sync();
#if RPT_SYNC
    g.sync();
#endif
    __builtin_amdgcn_fence(__ATOMIC_ACQUIRE, "agent");
    asm volatile("s_waitcnt vmcnt(0)" ::: "memory");
}
struct EpiSwiGLU {
    static constexpr bool PERM = true, AFTER_DRAIN = false;
    bf16* O; int ldc;
    __device__ __forceinline__ void operator()(const f32x4 (&acc)[2][2][4][2], const pg8::Unit& u, int wr, int wc, int fr, int fq) const {
        const int row0 = u.pm * 256 + wr * 64 + fr, col0 = u.pn * 128 + wc * 32 + 8 * fq;
#pragma unroll
        for (int ai = 0; ai < 2; ++ai)
#pragma unroll
            for (int m = 0; m < 4; ++m) {
                bf16* rowp = O + (size_t)(row0 + ai * 128 + m * 16) * ldc + col0;
                float r[8];
#pragma unroll
                for (int n = 0; n < 2; ++n)
#pragma unroll
                    for (int i = 0; i < 4; ++i) { const float g = acc[ai][0][m][n][i], up = acc[ai][1][m][n][i];
                        r[n * 4 + i] = g * fast_rcp(1.0f + fast_exp2(-g * LOG2E)) * up; }
                u32x4 w; w.x = pk2(r[0], r[1]); w.y = pk2(r[2], r[3]); w.z = pk2(r[4], r[5]); w.w = pk2(r[6], r[7]);
                *(u32x4*)rowp = w;
            }
    }
};
template <int HALFW>
struct EpiResid {
    static constexpr bool PERM = true, AFTER_DRAIN = false;
    unsigned char* ws; const f16* xres; f16* out; int code;
    __device__ __forceinline__ void operator()(const f32x4 (&acc)[2][2][4][2], const pg8::Unit& u, int wr, int wc, int fr, int fq) const {
        typedef _Float16 f16x8 __attribute__((ext_vector_type(8))); typedef float f32x8 __attribute__((ext_vector_type(8)));
        const float w = HALFW ? 0.5f : 1.0f;
        const int b = u.pm >> 4; const float* gb = (const float*)(ws + WS_MOD) + (size_t)(code & 1023) * 1024 + (size_t)b * MODW;
        const float* lg = (const float*)ws + (size_t)((code >> 10) & 1023) * 1024; const float* lb = (const float*)ws + (size_t)((code >> 20) & 1023) * 1024;
        const float* stats = (const float*)(ws + WS_STATS);
        const int col0 = u.pn * 256 + wc * 32 + 8 * fq, rowb = u.pm * 256 + wr * 64 + fr;
        float mu[8], rs[8];
#pragma unroll
        for (int q = 0; q < 8; ++q) { const int row = rowb + (q >> 2) * 128 + (q & 3) * 16; mu[q] = stats[2 * row]; rs[q] = stats[2 * row + 1]; }
        f16x8 xin[2][2];
#define ER_LOAD(bt_, slot_) do { const int col_ = col0 + ((bt_) >> 2) * 128, r0_ = rowb + (((bt_) >> 1) & 1) * 128 + ((bt_) & 1) * 32; _Pragma("unroll") for (int m_ = 0; m_ < 2; ++m_) \
            xin[slot_][m_] = *(const f16x8*)(xres + (size_t)(r0_ + m_ * 16) * DM + col_); } while (0)
        ER_LOAD(0, 0);
        f32x4 gma, gmb, g4a, g4b, b4a, b4b;
#pragma unroll
        for (int bt = 0; bt < 8; ++bt) {
            const int bj = bt >> 2, ai = (bt >> 1) & 1, mp = bt & 1, col = col0 + bj * 128;
            if ((bt & 3) == 0) { const f32x4 gva = *(const f32x4*)(gb + col), gvb = *(const f32x4*)(gb + col + 4); gma = (gva + 1.0f) * w; gmb = (gvb + 1.0f) * w;
                g4a = *(const f32x4*)(lg + col); g4b = *(const f32x4*)(lg + col + 4); b4a = *(const f32x4*)(lb + col); b4b = *(const f32x4*)(lb + col + 4); }
            if (bt + 1 < 8) ER_LOAD(bt + 1, (bt + 1) & 1);
#pragma unroll
            for (int mm = 0; mm < 2; ++mm) { const int m = 2 * mp + mm, q = ai * 4 + m; const size_t off = (size_t)(rowb + ai * 128 + m * 16) * DM + col;
                const f32x8 xf = __builtin_convertvector(xin[bt & 1][mm], f32x8);
                f32x4 xa = {xf[0], xf[1], xf[2], xf[3]}, xb = {xf[4], xf[5], xf[6], xf[7]};
                xa = (xa - mu[q]) * rs[q] * g4a + b4a; xb = (xb - mu[q]) * rs[q] * g4b + b4b;
                const f32x4 oa = xa * ALPHA + gma * acc[ai][bj][m][0], ob = xb * ALPHA + gmb * acc[ai][bj][m][1];
                const f32x8 of = {oa[0], oa[1], oa[2], oa[3], ob[0], ob[1], ob[2], ob[3]};
                *(f16x8*)(out + off) = __builtin_convertvector(of, f16x8); }
        }
#undef ER_LOAD
    }
};
struct EpiProj {
    static constexpr bool PERM = true, AFTER_DRAIN = false;
    bf16* O; int ldc;
    int q_end, rope_end, idx_lo, idx_hi, w_lo, f_lo;
    float* flog;
    const float *cos16, *sin16, *cos8, *sin8;
    __device__ __forceinline__ void operator()(const f32x4 (&acc)[2][2][4][2], const pg8::Unit& u, int wr, int wc, int fr, int fq) const {
#pragma unroll
        for (int bj = 0; bj < 2; ++bj) {
            const int cbase = u.pn * 256 + bj * 128 + wc * 32;
            const bool r64 = cbase < rope_end && (cbase & 63) == 0;
            const bool r32 = cbase >= idx_lo && cbase < idx_hi;
            const float sc = cbase < q_end ? C2 : 1.0f;
            const bool isw = cbase == w_lo, isf = cbase == f_lo;
#pragma unroll
            for (int ai = 0; ai < 2; ++ai)
#pragma unroll
                for (int m = 0; m < 4; ++m) {
                    const int row = u.pm * 256 + ai * 128 + wr * 64 + m * 16 + fr, pos = row & (SEQ - 1);
                    f32x4 v0 = acc[ai][bj][m][0], v1 = acc[ai][bj][m][1];
                    if (r64) {
                        f32x4 o0, o1;
#pragma unroll
                        for (int i = 0; i < 4; ++i) { o0[i] = __shfl_xor(v0[i], 16); o1[i] = __shfl_xor(v1[i], 16); }
                        if (fq < 2) {
                            const f32x4 c0 = *(const f32x4*)(cos16 + pos * 8), c1 = *(const f32x4*)(cos16 + pos * 8 + 4);
                            const f32x4 s0 = *(const f32x4*)(sin16 + pos * 8), s1 = *(const f32x4*)(sin16 + pos * 8 + 4);
                            const float sg = fq == 0 ? -1.0f : 1.0f;
                            v0 = v0 * c0 + (o0 * s0) * sg; v1 = v1 * c1 + (o1 * s1) * sg;
                        }
                    }
                    if (r32 && fq == 0) {
                        const f32x4 c = *(const f32x4*)(cos8 + pos * 4), s = *(const f32x4*)(sin8 + pos * 4);
                        const f32x4 n0 = v0 * c - v1 * s, n1 = v1 * c + v0 * s; v0 = n0; v1 = n1;
                    }
                    if (isw && fq == 0) { v0 = v0 * 0.0625f; v1 = v1 * 0.0625f; }
                    if (isf && fq < 2) { *(f32x4*)(flog + (size_t)row * 16 + 8 * fq) = v0; *(f32x4*)(flog + (size_t)row * 16 + 8 * fq + 4) = v1; }
                    v0 = v0 * sc; v1 = v1 * sc;
                    u32x4 w; w.x = pk2(v0[0], v0[1]); w.y = pk2(v0[2], v0[3]); w.z = pk2(v1[0], v1[1]); w.w = pk2(v1[2], v1[3]);
                    *(u32x4*)(O + (size_t)row * ldc + cbase + 8 * fq) = w;
                }
        }
    }
};

__device__ __forceinline__ float wave_sum(float v) {
#pragma unroll
    for (int o = 1; o < 64; o <<= 1) v += __shfl_xor(v, o);
    return v;
}
__device__ __forceinline__ int wave_isum(int v) {
#pragma unroll
    for (int o = 1; o < 64; o <<= 1) v += __shfl_xor(v, o);
    return v;
}
struct ConvDesc { const float* W; bf16* WT; int K, N, Npad, item; bool ffn; };
__device__ __forceinline__ void conv_load(const ConvDesc& d, int lane, f32x4 (&ld)[8]) {
    const int nblk = d.Npad / 32, kb = d.item / nblk, nb = d.item % nblk, k0 = 64 * kb, n0 = 32 * nb;
    int sc0 = n0; if (d.ffn) { const int t = n0 >> 8, s = (n0 >> 7) & 1, r = n0 & 127; sc0 = s * FF + 128 * t + r; }
    const int c4 = lane & 7, col = sc0 + 4 * c4; const bool ok = col < d.N;
#pragma unroll
    for (int i = 0; i < 8; ++i) { const int kk = (lane >> 3) + 8 * i; ld[i] = ok ? *(const f32x4*)(d.W + (size_t)(k0 + kk) * d.N + col) : (f32x4){0.f, 0.f, 0.f, 0.f}; }
}
__device__ __forceinline__ void conv_store(const ConvDesc& d, LAS float* scr, int lane, const f32x4 (&ld)[8]) {
    const int nblk = d.Npad / 32, kb = d.item / nblk, nb = d.item % nblk, k0 = 64 * kb, n0 = 32 * nb, c4 = lane & 7;
#pragma unroll
    for (int i = 0; i < 8; ++i) { const int kk = (lane >> 3) + 8 * i; LAS float* p = scr + kk * 33 + 4 * c4; p[0] = ld[i][0]; p[1] = ld[i][1]; p[2] = ld[i][2]; p[3] = ld[i][3]; }
    LDS_WAIT(); asm volatile("" ::: "memory");
    const int c = lane & 7;
#pragma unroll
    for (int j = 0; j < 4; ++j) { const int n = (lane >> 3) + 8 * j; const LAS float* s = scr + (8 * c) * 33 + n;
        u32x4 o; o.x = pk2(s[0 * 33], s[1 * 33]); o.y = pk2(s[2 * 33], s[3 * 33]); o.z = pk2(s[4 * 33], s[5 * 33]); o.w = pk2(s[6 * 33], s[7 * 33]);
        *(u32x4*)(d.WT + (size_t)(n0 + n) * d.K + k0 + 8 * c) = o; }
    LDS_WAIT(); asm volatile("" ::: "memory");
}
template <bool SRC16>
__device__ __forceinline__ void ln_rows(const void* srcv, f16* v16out, float* xout, bf16* hout, const float* g, const float* bt, const float* scale, const float* shift,
                                        bool do_ln, bool write_h, float pre, float* stats, bool write_x) {
    int tid_ = threadIdx.x; asm volatile("" : "+v"(tid_));
    const int lane = tid_ & 63, gw = blockIdx.x * NWAVES + __builtin_amdgcn_readfirstlane(tid_ >> 6), ngw = gridDim.x * NWAVES;
    typedef _Float16 f16x8 __attribute__((ext_vector_type(8))); typedef float f32x8 __attribute__((ext_vector_type(8)));
#define FI(j) (2 * lane + 128 * ((j) >> 1) + ((j) & 1))
    f16x8 nx16[4][2]; f32x4 nx32[4][4];
#define LN_LOAD(mbase) do { _Pragma("unroll") for (int r = 0; r < 4; ++r) { const int mr_ = (mbase) + r; const int mc_ = mr_ < M ? mr_ : (mbase); \
        if (SRC16) { const f16x8* xr = (const f16x8*)((const f16*)srcv + (size_t)mc_ * DM) + lane; _Pragma("unroll") for (int jj = 0; jj < 2; ++jj) nx16[r][jj] = xr[64 * jj]; } \
        else { const f32x4* xr = (const f32x4*)((const float*)srcv + (size_t)mc_ * DM); _Pragma("unroll") for (int j = 0; j < 4; ++j) nx32[r][j] = xr[FI(j)]; } } } while (0)
    if (4 * gw < M) LN_LOAD(4 * gw);
    for (int m0 = 4 * gw; m0 < M; m0 += 4 * ngw) {
        int mm[4]; bool has[4];
#pragma unroll
        for (int r = 0; r < 4; ++r) { const int mr = m0 + r; has[r] = mr < M; mm[r] = has[r] ? mr : m0; }
        f32x4 v[4][4];
#pragma unroll
        for (int r = 0; r < 4; ++r) {
            if (SRC16) {
#pragma unroll
                for (int jj = 0; jj < 2; ++jj) { const f32x8 f = __builtin_convertvector(nx16[r][jj], f32x8);
                    v[r][2 * jj] = (f32x4){f[0], f[1], f[2], f[3]} * pre; v[r][2 * jj + 1] = (f32x4){f[4], f[5], f[6], f[7]} * pre; }
            } else {
#pragma unroll
                for (int j = 0; j < 4; ++j) v[r][j] = nx32[r][j] * pre;
            }
        }
        if (m0 + 4 * ngw < M) LN_LOAD(m0 + 4 * ngw);
#pragma unroll
        for (int r = 0; r < 4; ++r) {
            if (!has[r]) continue;
            const int m = mm[r], b = m >> 12;
            if (!do_ln && stats && lane == 0) { stats[2 * m] = 0.f; stats[2 * m + 1] = 1.f; }
            if (!SRC16 && v16out) { f16x8* vo = (f16x8*)(v16out + (size_t)m * DM) + lane;
#pragma unroll
                for (int jj = 0; jj < 2; ++jj) { const f32x4 a0 = v[r][2 * jj], a1 = v[r][2 * jj + 1]; const f32x8 f = {a0[0], a0[1], a0[2], a0[3], a1[0], a1[1], a1[2], a1[3]};
                    vo[64 * jj] = __builtin_convertvector(f, f16x8); } }
            if (do_ln) {
                float s = 0.f;
#pragma unroll
                for (int j = 0; j < 4; ++j) s += (v[r][j][0] + v[r][j][1]) + (v[r][j][2] + v[r][j][3]);
                const float mean = wave_sum(s) * (1.f / DM); float s2 = 0.f;
#pragma unroll
                for (int j = 0; j < 4; ++j) { v[r][j] = v[r][j] - mean; s2 += (v[r][j][0] * v[r][j][0] + v[r][j][1] * v[r][j][1]) + (v[r][j][2] * v[r][j][2] + v[r][j][3] * v[r][j][3]); }
                const float rstd = 1.0f / sqrtf(wave_sum(s2) * (1.f / DM) + LN_EPS);
                if (stats && lane == 0) { stats[2 * m] = mean; stats[2 * m + 1] = rstd; }
                f32x4* xo = (f32x4*)(xout + (size_t)m * DM);
#pragma unroll
                for (int j = 0; j < 4; ++j) { const f32x4 gg = *((const f32x4*)g + FI(j)), bb = *((const f32x4*)bt + FI(j));
                    v[r][j] = v[r][j] * rstd * gg + bb; if (write_x) xo[FI(j)] = v[r][j]; }
            }
            if (write_h) {
                const f32x4* sc = (const f32x4*)(scale + (size_t)b * MODW); const f32x4* sh = (const f32x4*)(shift + (size_t)b * MODW);
                u32x4* ho = (u32x4*)(hout + (size_t)m * DM) + lane;
#pragma unroll
                for (int jj = 0; jj < 2; ++jj) { const f32x4 h0 = v[r][2 * jj] * (sc[FI(2 * jj)] + 1.0f) + sh[FI(2 * jj)], h1 = v[r][2 * jj + 1] * (sc[FI(2 * jj + 1)] + 1.0f) + sh[FI(2 * jj + 1)];
                    u32x4 w; w.x = pk2(h0[0], h0[1]); w.y = pk2(h0[2], h0[3]); w.z = pk2(h1[0], h1[1]); w.w = pk2(h1[2], h1[3]); ho[64 * jj] = w; }
            }
        }
    }
#undef LN_LOAD
#undef FI
}
constexpr int KROW = 144;
__device__ __forceinline__ f32x16 mfma32(bf16x8 a, bf16x8 b, f32x16 c) { return __builtin_amdgcn_mfma_f32_32x32x16_bf16(a, b, c, 0, 0, 0); }

template <int DV, int MODE>
__device__ __forceinline__ void attn_tile(LAS const unsigned char* Kb, const bf16x8 (&qr)[4], f32x16 (&o)[DV / 32], float& m, float& l,
                                          const int t, const int q0, const int wid, const int r32, const int hi, const int qpos, const unsigned long long (&bw)[4]) {
    constexpr int KB = 64 * KROW, VB = DV * KROW;
    LAS const unsigned char* VTb = Kb + KB; LAS const float* Bb = (LAS const float*)(Kb + KB + VB);
    f32x16 p[2];
#pragma unroll
    for (int half = 0; half < 2; ++half) {
        if (MODE == 0) {
#pragma unroll
            for (int g = 0; g < 4; ++g) { const f32x4 bv = *(LAS const f32x4*)(Bb + 32 * half + 8 * g + 4 * hi);
                p[half][4 * g] = bv[0]; p[half][4 * g + 1] = bv[1]; p[half][4 * g + 2] = bv[2]; p[half][4 * g + 3] = bv[3]; }
        } else {
#pragma unroll
            for (int r = 0; r < 16; ++r) p[half][r] = 0.f;
        }
#pragma unroll
        for (int d0 = 0; d0 < 4; ++d0) { const bf16x8 kf = *(LAS const bf16x8*)(Kb + (32 * half + r32) * KROW + (2 * d0 + hi) * 16); p[half] = mfma32(kf, qr[d0], p[half]); }
    }
    const int kv0 = 64 * t + 4 * hi;
    if (MODE == 0 || MODE == 1) {
        if (64 * t + 63 > q0 + 32 * wid) {
#pragma unroll
            for (int half = 0; half < 2; ++half)
#pragma unroll
                for (int r = 0; r < 16; ++r) { const int kv = kv0 + 32 * half + 8 * (r >> 2) + (r & 3); if (kv > qpos) p[half][r] = NEGBIG; }
        }
    }
    if (MODE == 2) {
#pragma unroll
        for (int half = 0; half < 2; ++half)
#pragma unroll
            for (int r = 0; r < 16; ++r) { const int d = qpos - (kv0 + 32 * half + 8 * (r >> 2) + (r & 3)); if (d < 0 || d >= 128) p[half][r] = NEGBIG; }
    }
    if (MODE == 3) {
        unsigned wsh[4];
#pragma unroll
        for (int i = 0; i < 4; ++i) wsh[i] = (unsigned)(bw[i] >> (16 * (t & 3) + hi));
#pragma unroll
        for (int half = 0; half < 2; ++half)
#pragma unroll
            for (int r = 0; r < 16; ++r) { if (!((wsh[r & 3] >> (8 * half + 2 * (r >> 2))) & 1u)) p[half][r] = NEGBIG; }
    }
    float mx = fmaxf(p[0][0], p[1][0]);
#pragma unroll
    for (int r = 1; r < 16; ++r) mx = fmaxf(mx, fmaxf(p[0][r], p[1][r]));
    mx = fmaxf(mx, __shfl_xor(mx, 32));
    const float mnew = fmaxf(m, mx);
    if (!__all(mnew == m)) {
        const float alpha = fast_exp2(m - mnew); l *= alpha; m = mnew;
#pragma unroll
        for (int dh = 0; dh < DV / 32; ++dh)
#pragma unroll
            for (int r = 0; r < 16; ++r) o[dh][r] *= alpha;
    }
    float ls = 0.f;
#pragma unroll
    for (int half = 0; half < 2; ++half)
#pragma unroll
        for (int r = 0; r < 16; ++r) { const float e = fast_exp2(p[half][r] - m); p[half][r] = e; ls += e; }
    l += ls;
#pragma unroll
    for (int half = 0; half < 2; ++half)
#pragma unroll
        for (int c = 0; c < 2; ++c) {
            u32x4 pw; pw.x = pk2(p[half][8 * c], p[half][8 * c + 1]); pw.y = pk2(p[half][8 * c + 2], p[half][8 * c + 3]);
            pw.z = pk2(p[half][8 * c + 4], p[half][8 * c + 5]); pw.w = pk2(p[half][8 * c + 6], p[half][8 * c + 7]);
            const bf16x8 pf = __builtin_bit_cast(bf16x8, pw);
#pragma unroll
            for (int dh = 0; dh < DV / 32; ++dh) { const bf16x8 vf = *(LAS const bf16x8*)(VTb + (32 * dh + r32) * KROW + (32 * half + 16 * c + 8 * hi) * 2); o[dh] = mfma32(vf, pf, o[dh]); }
        }
}

template <int DV, int MODE>
__device__ __forceinline__ void attn_core(LAS unsigned char* lds, const bf16* Qrow, const bf16* Kp, int ldk, const bf16* Vp, int ldv,
                                          const float* kb, const unsigned long long* bmrow, int q0, int t_lo, int t_hi, float m_init, float l_init,
                                          f32x16 (&o)[DV / 32], float& l_out) {
    int tid_ = threadIdx.x; asm volatile("" : "+v"(tid_));
    const int tid = tid_, lane = tid & 63, wid = __builtin_amdgcn_readfirstlane(tid >> 6), r32 = lane & 31, hi = lane >> 5;
    constexpr int KB = 64 * KROW, VB = DV * KROW, BUF = KB + VB + 256, NV = DV / 64;
    bf16x8 qr[4];
#pragma unroll
    for (int d0 = 0; d0 < 4; ++d0) qr[d0] = *(const bf16x8*)(Qrow + 16 * d0 + 8 * hi);
    const int qpos = q0 + 32 * wid + r32;
    float m = m_init, l = (hi == 0) ? l_init : 0.f;
#pragma unroll
    for (int dh = 0; dh < DV / 32; ++dh)
#pragma unroll
        for (int r = 0; r < 16; ++r) o[dh][r] = 0.f;
    const int krow = tid >> 3, kch = tid & 7, vkv = lane, vch = wid;
    const int vpos = (vkv & ~15) | (((vkv >> 2) & 1) << 3) | (((vkv >> 3) & 1) << 2) | (vkv & 3);
    u32x4 kregA, kregB, vregA[NV], vregB[NV]; float bregA = 0.f, bregB = 0.f;
#define AT_GLOAD(R, t) do { kreg##R = *(const u32x4*)(Kp + (size_t)(64 * (t) + krow) * ldk + kch * 8); \
        _Pragma("unroll") for (int i_ = 0; i_ < NV; ++i_) vreg##R[i_] = *(const u32x4*)(Vp + (size_t)(64 * (t) + vkv) * ldv + (vch + 8 * i_) * 8); \
        if (MODE == 0) { if (tid < 64) breg##R = kb[64 * (t) + tid]; } } while (0)
#define AT_LSTORE(R, buf) do { LAS unsigned char* b_ = lds + (buf) * BUF; *(LAS u32x4*)(b_ + krow * KROW + kch * 16) = kreg##R; \
        _Pragma("unroll") for (int i_ = 0; i_ < NV; ++i_) _Pragma("unroll") for (int j_ = 0; j_ < 8; ++j_) \
            *(LAS unsigned short*)(b_ + KB + ((vch + 8 * i_) * 8 + j_) * KROW + vpos * 2) = (unsigned short)(vreg##R[i_][j_ >> 1] >> (16 * (j_ & 1))); \
        if (MODE == 0) { if (tid < 64) *(LAS float*)(b_ + KB + VB + tid * 4) = breg##R; } } while (0)
#define AT_NEED(t) ((64 * (t) <= q0 + 32 * wid + 31) && (MODE != 2 || (64 * (t) + 63 >= q0 + 32 * wid - 127)))
    unsigned long long bw[4] = {0ull, 0ull, 0ull, 0ull}, bwn[4] = {0ull, 0ull, 0ull, 0ull};
#define AT_MASK(tt) do { if (MODE == 3) { if (((tt) & 3) == 0) { _Pragma("unroll") for (int i_ = 0; i_ < 4; ++i_) bw[i_] = bwn[i_]; } \
        if (((tt) & 3) == 3 && (tt) + 1 < t_hi) { _Pragma("unroll") for (int i_ = 0; i_ < 4; ++i_) bwn[i_] = bmrow[4 * (((tt) + 1) >> 2) + i_]; } } } while (0)
    if (MODE == 3) {
#pragma unroll
        for (int i = 0; i < 4; ++i) bwn[i] = bmrow[4 * (t_lo >> 2) + i]; }
    AT_GLOAD(A, t_lo); if (t_lo + 1 < t_hi) AT_GLOAD(B, t_lo + 1);
    AT_LSTORE(A, 0); __syncthreads();
    for (int t = t_lo; t < t_hi; t += 2) {
        AT_MASK(t);
        if (t + 2 < t_hi) AT_GLOAD(A, t + 2);
        if (AT_NEED(t)) attn_tile<DV, MODE>(lds, qr, o, m, l, t, q0, wid, r32, hi, qpos, bw);
        if (t + 1 < t_hi) AT_LSTORE(B, 1);
        __syncthreads();
        if (t + 1 >= t_hi) break;
        AT_MASK(t + 1);
        if (t + 3 < t_hi) AT_GLOAD(B, t + 3);
        if (AT_NEED(t + 1)) attn_tile<DV, MODE>(lds + BUF, qr, o, m, l, t + 1, q0, wid, r32, hi, qpos, bw);
        if (t + 2 < t_hi) AT_LSTORE(A, 0);
        __syncthreads();
    }
#undef AT_GLOAD
#undef AT_LSTORE
#undef AT_NEED
#undef AT_MASK
    l_out = l + __shfl_xor(l, 32);
}
template <int DV, int MODE>
__device__ __forceinline__ void attn_core_h2(LAS unsigned char* lds, const bf16* Qrow, const bf16* Qrow2, const bf16* Kp, int ldk, const bf16* Vp, int ldv,
                                          const float* kb, const unsigned long long* bmrow, int q0, int t_lo, int t_hi, float m_init, float l_init,
                                          f32x16 (&o)[DV / 32], float& l_out, f32x16 (&o2)[DV / 32], float& l_out2) {
    int tid_ = threadIdx.x; asm volatile("" : "+v"(tid_));
    const int tid = tid_, lane = tid & 63, wid = __builtin_amdgcn_readfirstlane(tid >> 6), r32 = lane & 31, hi = lane >> 5;
    constexpr int KB = 64 * KROW, VB = DV * KROW, BUF = KB + VB + 256, NV = DV / 64;
    bf16x8 qr[4], qr2[4];
#pragma unroll
    for (int d0 = 0; d0 < 4; ++d0) { qr[d0] = *(const bf16x8*)(Qrow + 16 * d0 + 8 * hi); qr2[d0] = *(const bf16x8*)(Qrow2 + 16 * d0 + 8 * hi); }
    const int qpos = q0 + 32 * wid + r32;
    float m = m_init, l = (hi == 0) ? l_init : 0.f, m2 = m_init, l2 = l;
#pragma unroll
    for (int dh = 0; dh < DV / 32; ++dh)
#pragma unroll
        for (int r = 0; r < 16; ++r) { o[dh][r] = 0.f; o2[dh][r] = 0.f; }
    const int krow = tid >> 3, kch = tid & 7, vkv = lane, vch = wid;
    const int vpos = (vkv & ~15) | (((vkv >> 2) & 1) << 3) | (((vkv >> 3) & 1) << 2) | (vkv & 3);
    u32x4 kregA, kregB, vregA[NV], vregB[NV]; float bregA = 0.f, bregB = 0.f;
#define AT_GLOAD(R, t) do { kreg##R = *(const u32x4*)(Kp + (size_t)(64 * (t) + krow) * ldk + kch * 8); \
        _Pragma("unroll") for (int i_ = 0; i_ < NV; ++i_) vreg##R[i_] = *(const u32x4*)(Vp + (size_t)(64 * (t) + vkv) * ldv + (vch + 8 * i_) * 8); \
        if (MODE == 0) { if (tid < 64) breg##R = kb[64 * (t) + tid]; } } while (0)
#define AT_LSTORE(R, buf) do { LAS unsigned char* b_ = lds + (buf) * BUF; *(LAS u32x4*)(b_ + krow * KROW + kch * 16) = kreg##R; \
        _Pragma("unroll") for (int i_ = 0; i_ < NV; ++i_) _Pragma("unroll") for (int j_ = 0; j_ < 8; ++j_) \
            *(LAS unsigned short*)(b_ + KB + ((vch + 8 * i_) * 8 + j_) * KROW + vpos * 2) = (unsigned short)(vreg##R[i_][j_ >> 1] >> (16 * (j_ & 1))); \
        if (MODE == 0) { if (tid < 64) *(LAS float*)(b_ + KB + VB + tid * 4) = breg##R; } } while (0)
#define AT_NEED(t) ((64 * (t) <= q0 + 32 * wid + 31) && (MODE != 2 || (64 * (t) + 63 >= q0 + 32 * wid - 127)))
    unsigned long long bw[4] = {0ull, 0ull, 0ull, 0ull}, bwn[4] = {0ull, 0ull, 0ull, 0ull};
#define AT_MASK(tt) do { if (MODE == 3) { if (((tt) & 3) == 0) { _Pragma("unroll") for (int i_ = 0; i_ < 4; ++i_) bw[i_] = bwn[i_]; } \
        if (((tt) & 3) == 3 && (tt) + 1 < t_hi) { _Pragma("unroll") for (int i_ = 0; i_ < 4; ++i_) bwn[i_] = bmrow[4 * (((tt) + 1) >> 2) + i_]; } } } while (0)
    if (MODE == 3) {
#pragma unroll
        for (int i = 0; i < 4; ++i) bwn[i] = bmrow[4 * (t_lo >> 2) + i]; }
    AT_GLOAD(A, t_lo); if (t_lo + 1 < t_hi) AT_GLOAD(B, t_lo + 1);
    AT_LSTORE(A, 0); __syncthreads();
    for (int t = t_lo; t < t_hi; t += 2) {
        AT_MASK(t);
        if (t + 2 < t_hi) AT_GLOAD(A, t + 2);
        if (AT_NEED(t)) { attn_tile<DV, MODE>(lds, qr, o, m, l, t, q0, wid, r32, hi, qpos, bw); attn_tile<DV, MODE>(lds, qr2, o2, m2, l2, t, q0, wid, r32, hi, qpos, bw); }
        if (t + 1 < t_hi) AT_LSTORE(B, 1);
        __syncthreads();
        if (t + 1 >= t_hi) break;
        AT_MASK(t + 1);
        if (t + 3 < t_hi) AT_GLOAD(B, t + 3);
        if (AT_NEED(t + 1)) { attn_tile<DV, MODE>(lds + BUF, qr, o, m, l, t + 1, q0, wid, r32, hi, qpos, bw); attn_tile<DV, MODE>(lds + BUF, qr2, o2, m2, l2, t + 1, q0, wid, r32, hi, qpos, bw); }
        if (t + 2 < t_hi) AT_LSTORE(A, 0);
        __syncthreads();
    }
#undef AT_GLOAD
#undef AT_LSTORE
#undef AT_NEED
#undef AT_MASK
    l_out = l + __shfl_xor(l, 32); l_out2 = l2 + __shfl_xor(l2, 32);
}
template <int DV>
__device__ __forceinline__ void store_o(const f32x16 (&o)[DV / 32], float inv, bf16* orow, int hi) {
#pragma unroll
    for (int dh = 0; dh < DV / 32; ++dh)
#pragma unroll
        for (int g = 0; g < 4; ++g) { u32x2 w; w.x = pk2(o[dh][4 * g] * inv, o[dh][4 * g + 1] * inv); w.y = pk2(o[dh][4 * g + 2] * inv, o[dh][4 * g + 3] * inv);
            *(u32x2*)(orow + 32 * dh + 8 * g + 4 * hi) = w; }
}


__device__ __forceinline__ size_t sc_rowoff(int b, int q) { const int Gq = q >> 8; return (size_t)b * 8912896 + (size_t)65536 * (Gq * (Gq + 1) / 2) + (size_t)(q & 255) * 256 * (Gq + 1); }
__device__ __forceinline__ void select_load(const float* srow, const int nj, const int lane, f32x4 (&raw)[16]) {
#pragma unroll
    for (int j = 0; j < 16; ++j) { if (j < nj) raw[j] = *(const f32x4*)(srow + 256 * j + 4 * lane); }
}
__device__ __forceinline__ unsigned long long select_row(const f32x4 (&raw)[16], const int t, const int nj, const int lane) {
                unsigned key[16][4];
#pragma unroll
                for (int j = 0; j < 16; ++j) {
                    if (j < nj) {
#pragma unroll
                        for (int i = 0; i < 4; ++i) { const float fv = raw[j][i]; const unsigned uu = __float_as_uint(fv); const unsigned k = (uu & 0x80000000u) ? ~uu : (uu | 0x80000000u);
                            key[j][i] = (256 * j + 4 * lane + i <= t) ? k : 0u; } }
                    else { key[j][0] = 0u; key[j][1] = 0u; key[j][2] = 0u; key[j][3] = 0u; }
                }
                unsigned tau = 1u, I = 0xFFFFFFFFu;
                if (t >= 256) {
                    bool early = false; unsigned prefix = 0u, krem = 256u, msz = (unsigned)t + 1u;
#pragma unroll 1
                    for (int bit = 31; bit >= 0; --bit) {
                        const unsigned cand = prefix | (1u << bit), mh = ~((1u << bit) - 1u); int cnt = 0;
#pragma unroll
                        for (int j = 0; j < 16; ++j) if (j < nj) {
#pragma unroll
                            for (int i = 0; i < 4; ++i) cnt += (int)__popcll(__ballot((key[j][i] & mh) == cand));
                            __builtin_amdgcn_sched_barrier(0); }
                        if ((unsigned)cnt >= krem) { prefix = cand; msz = (unsigned)cnt; } else { krem -= (unsigned)cnt; msz -= (unsigned)cnt; }
                        if (msz == krem) { early = true; break; }
                    }
                    tau = prefix; int ceq = 0;
                    if (!early) {
#pragma unroll
                    for (int j = 0; j < 16; ++j) if (j < nj) {
#pragma unroll
                        for (int i = 0; i < 4; ++i) ceq += (key[j][i] == tau) ? 1 : 0;
                        __builtin_amdgcn_sched_barrier(0); }
                    ceq = wave_isum(ceq); }
                    if ((unsigned)ceq > krem) {
                        unsigned pre = 0u, nd = krem;
#pragma unroll 1
                        for (int bit = 11; bit >= 0; --bit) {
                            const unsigned mh = (~((1u << bit) - 1u)) & 0xFFFu; int cnt = 0;
#pragma unroll
                            for (int j = 0; j < 16; ++j) if (j < nj) {
#pragma unroll
                                for (int i = 0; i < 4; ++i) cnt += (key[j][i] == tau && (((unsigned)(256 * j + 4 * lane + i)) & mh) == pre) ? 1 : 0;
                                __builtin_amdgcn_sched_barrier(0); }
                            cnt = wave_isum(cnt);
                            if ((unsigned)cnt < nd) { nd -= (unsigned)cnt; pre |= 1u << bit; }
                        }
                        I = pre;
                    }
                }
                unsigned long long myw = 0ull;
#pragma unroll
                for (int j = 0; j < 16; ++j) if (j < nj) {
#pragma unroll
                    for (int i = 0; i < 4; ++i) { const unsigned idx = (unsigned)(256 * j + 4 * lane + i);
                        const unsigned long long w = __ballot(key[j][i] > tau || (key[j][i] == tau && idx <= I)); if (lane == 4 * j + i) myw = w; }
                    __builtin_amdgcn_sched_barrier(0); }
                return myw;
}
#ifdef ORACLE
__device__ __forceinline__ float wave_max(float v) {
#pragma unroll
    for (int o = 1; o < 64; o <<= 1) v = fmaxf(v, __shfl_xor(v, o));
    return v;
}
__device__ __forceinline__ void oracle_row(const int MODE, const int DV, const bf16* Qrow, const bf16* Kp, int ldk, const bf16* Vp, int ldv, const float* kb, const unsigned long long* bmrow,
                                           int t, float m_init, float l_init, float& o0, float& o1) {
    const int lane = threadIdx.x & 63;
    const float q = bf2f(Qrow[lane]);
    float m = m_init, l = l_init, a0 = 0.f, a1 = 0.f;
#pragma unroll 1
    for (int k = 0; k <= t; ++k) {
        if (MODE == 2 && t - k >= 128) continue;
        if (MODE == 3) { const int j = k >> 8, i = k & 3, lb = (k & 255) >> 2; if (!((bmrow[4 * j + i] >> lb) & 1ull)) continue; }
        float s = wave_sum(q * bf2f(Kp[(size_t)k * ldk + lane]));
        if (MODE == 0) s += kb[k];
        const float mn = fmaxf(m, s), al = exp2f(m - mn), e = exp2f(s - mn);
        l = l * al + e; a0 = a0 * al + e * bf2f(Vp[(size_t)k * ldv + lane]);
        if (DV == 128) a1 = a1 * al + e * bf2f(Vp[(size_t)k * ldv + 64 + lane]);
        m = mn;
    }
    o0 = a0 / l; o1 = a1 / l;
}
__device__ __forceinline__ void oracle_flag(unsigned char* ws, float err2, float ref2, int bit) {
    if ((threadIdx.x & 63) == 0 && !(err2 <= 0.0025f * ref2)) atomicOr((unsigned*)(ws + 900 * 1024), 1u << bit);
}
#endif
#ifdef ORACLE
__device__ __forceinline__ void oracle_check(unsigned char* ws_in, int L) {
    unsigned char* ws = opq(ws_in);
    int tid_ = threadIdx.x; asm volatile("" : "+v"(tid_));
    const int lane = tid_ & 63, gw = blockIdx.x * NWAVES + __builtin_amdgcn_readfirstlane(tid_ >> 6);
    const float* par = (const float*)ws; const bf16* ATT = (const bf16*)(ws + WS_ATT); const bf16* P = (const bf16*)(ws + WS_BIG);
    if (gw < 32) {
        const int ob = gw & 7, oh = (gw * 5) & 15, ti = (gw >> 2) & 7;
        const int ot = ti == 0 ? 3 : ti == 1 ? 77 : ti == 2 ? 255 : ti == 3 ? 256 : ti == 4 ? 700 : ti == 5 ? 1500 : ti == 6 ? 3000 : 4095;
        const size_t orow = (size_t)ob * SEQ + ot; float x0, x1;
        if (L == 0) {
            const bf16* KD = (const bf16*)(ws + WS_KD); const bf16* VD = (const bf16*)(ws + WS_VD); const unsigned long long* BM = (const unsigned long long*)(ws + WS_BM); const float* SC = (const float*)(ws + WS_SC);
            oracle_row(3, 64, P + orow * 1536 + oh * 64, KD + (size_t)ob * SEQ * 64, 64, VD + (size_t)ob * SEQ * 64, 64, nullptr, BM + orow * 64, ot, NEGBIG, 0.f, x0, x1);
            const float y = bf2f(ATT[orow * DM + oh * 64 + lane]);
            oracle_flag(ws, wave_sum((x0 - y) * (x0 - y)), wave_sum(x0 * x0), 0);
            const float* srow = SC + sc_rowoff(ob, ot); float mins = 3e38f, maxu = -3e38f; int cnt = 0;
            for (int k = lane; k <= ot; k += 64) { const int j = k >> 8, i = k & 3, lb = (k & 255) >> 2; const bool sel = (BM[orow * 64 + 4 * j + i] >> lb) & 1ull; const float s = srow[k];
                if (sel) { mins = fminf(mins, s); ++cnt; } else maxu = fmaxf(maxu, s); }
            cnt = wave_isum(cnt); mins = -wave_max(-mins); maxu = wave_max(maxu);
            const int want = ot + 1 < 256 ? ot + 1 : 256;
            oracle_flag(ws, (cnt == want && mins >= maxu) ? 0.f : 1.f, 1.f, 4);
        } else if (L == 1) {
            const float* CT = (const float*)(ws + WS_CUMT); const bf16* Pb = P + (size_t)ob * SEQ * 3328;
            oracle_row(0, 64, P + orow * 3328 + oh * 64, Pb + 1024 + oh * 64, 3328, Pb + 2048 + oh * 64, 3328, CT + (size_t)(ob * 16 + oh) * SEQ, nullptr, ot, NEGBIG, 0.f, x0, x1);
            const float y = bf2f(ATT[orow * DM + oh * 64 + lane]);
            oracle_flag(ws, wave_sum((x0 - y) * (x0 - y)), wave_sum(x0 * x0), 1);
        } else if (L == 2) {
            const bf16* Pb = P + (size_t)ob * SEQ * 1280; const int gk = oh >> 3;
            oracle_row(2, 64, P + orow * 1280 + oh * 64, Pb + 1024 + gk * 64, 1280, Pb + 1152 + gk * 64, 1280, nullptr, nullptr, ot, par[PAR_SINK + oh] * LOG2E, 1.0f, x0, x1);
            const float y = bf2f(ATT[orow * DM + oh * 64 + lane]);
            oracle_flag(ws, wave_sum((x0 - y) * (x0 - y)), wave_sum(x0 * x0), 2);
        } else {
            const bf16* Pb = P + (size_t)ob * SEQ * 3072; const int hh = oh & 7; float z0, z1;
            const float lambda_init = 0.8f - 0.6f * 0.40656965974059911f;
            const float s01 = wave_sum(par[PAR_LAM + lane] * par[PAR_LAM + 64 + lane]), s23 = wave_sum(par[PAR_LAM + 128 + lane] * par[PAR_LAM + 192 + lane]);
            const float lam = expf(s01) - expf(s23) + lambda_init;
            oracle_row(1, 128, P + orow * 3072 + (2 * hh) * 64, Pb + 1024 + (2 * hh) * 64, 3072, Pb + 2048 + hh * 128, 3072, nullptr, nullptr, ot, NEGBIG, 0.f, x0, x1);
            oracle_row(1, 128, P + orow * 3072 + (2 * hh + 1) * 64, Pb + 1024 + (2 * hh + 1) * 64, 3072, Pb + 2048 + hh * 128, 3072, nullptr, nullptr, ot, NEGBIG, 0.f, z0, z1);
            float v0 = x0 - lam * z0, v1 = x1 - lam * z1; const float ss = wave_sum(v0 * v0 + v1 * v1);
            const float rs = (1.0f / sqrtf(ss * (1.0f / 128.0f) + 1e-6f)) * (1.0f - lambda_init);
            v0 *= rs * par[PAR_SUBLN + lane]; v1 *= rs * par[PAR_SUBLN + 64 + lane];
            const float y0 = bf2f(ATT[orow * DM + hh * 128 + lane]), y1 = bf2f(ATT[orow * DM + hh * 128 + 64 + lane]);
            oracle_flag(ws, wave_sum((v0 - y0) * (v0 - y0) + (v1 - y1) * (v1 - y1)), wave_sum(v0 * v0 + v1 * v1), 3);
        }
    }
}
__global__ void __launch_bounds__(NTHREADS) oracle_kernel(unsigned char* ws, int L) { oracle_check(ws, L); }
#endif

__device__ __forceinline__ void mixer_layer(unsigned char* ws_in, float* out, int L, LAS unsigned char* lds, const XcdBarrier& bar) {
    unsigned char* const ws = ws_in;
#define MIX_VARS() unsigned char* w_ = opq(ws); int tid_ = threadIdx.x; asm volatile("" : "+v"(tid_)); \
    const int tid = tid_, lane = tid & 63, wid = __builtin_amdgcn_readfirstlane(tid >> 6), r32 = lane & 31, hi = lane >> 5; \
    const int G = gridDim.x, gw = blockIdx.x * NWAVES + wid, ngw = G * NWAVES; \
    const int vcu = (G % 8 == 0) ? (int)(blockIdx.x % 8) * (G / 8) + (int)(blockIdx.x / 8) : (int)blockIdx.x;     \
    const float* par = (const float*)w_; bf16* const ATT = (bf16*)(w_ + WS_ATT); bf16* const P = (bf16*)(w_ + WS_BIG); \
    (void)vcu; (void)tid; (void)lane; (void)r32; (void)hi; (void)G; (void)gw; (void)ngw; (void)par; (void)ATT; (void)P
    {
        unsigned char* w_ = opq(ws); const int G = gridDim.x;
        const int Npad = L == 0 ? 1536 : L == 1 ? 3328 : L == 2 ? 1280 : 3072;
        const size_t woff = L == 0 ? W_DSA : L == 1 ? W_FOX : L == 2 ? W_SWA : W_DIFF;
        const float* cos16 = (const float*)(w_ + WS_ROPE); const float* sin16 = cos16 + SEQ * 8; const float* cos8 = sin16 + SEQ * 8; const float* sin8 = cos8 + SEQ * 4;
        pg8::Gemm g{(const bf16*)(w_ + WS_H), (const bf16*)(w_ + WS_W + woff), M, Npad, DM}; pg8::StaticOrder S; S.init(M, Npad, G, (int)blockIdx.x);
        EpiProj E; E.O = (bf16*)(w_ + WS_BIG); E.ldc = Npad; E.q_end = 1024; E.rope_end = L == 0 ? 1024 : L == 1 ? 0 : L == 2 ? 1152 : 2048;
        E.idx_lo = L == 0 ? 1152 : (1 << 30); E.idx_hi = L == 0 ? 1440 : (1 << 30); E.w_lo = L == 0 ? 1440 : -1; E.f_lo = L == 1 ? 3072 : -1;
        E.flog = (float*)(w_ + WS_FLOG); E.cos16 = cos16; E.sin16 = sin16; E.cos8 = cos8; E.sin8 = sin8;
        _Pragma("unroll 1") for (int rep_ = 0, nrep_ = opq_i(1 + RPT_INPROJ); rep_ < nrep_; ++rep_) pg8::gemm_phase<EpiProj, pg8::StaticOrder, true, true>(lds, g, S, E);
    }
    xsync(bar);
    if (L == 0) {
        {
            MIX_VARS(); bf16* const KD = (bf16*)(w_ + WS_KD); bf16* const VD = (bf16*)(w_ + WS_VD);
            const float* cos16 = (const float*)(w_ + WS_ROPE); const float* sin16 = cos16 + SEQ * 8;
            LAS float* Wl = (LAS float*)lds; LAS float* cn = (LAS float*)(lds + 65536 + wid * 2048);
            for (int i = tid; i < 16384; i += NTHREADS) Wl[i] = par[PAR_KVUP + i];
            __syncthreads();
            _Pragma("unroll 1") for (int rep_ = 0, nrep_ = opq_i(1 + RPT_DSAX); rep_ < nrep_; ++rep_)
            for (int t4 = gw; t4 < M / 4; t4 += ngw) {
#pragma unroll
                for (int tk = 0; tk < 4; ++tk) { const size_t row = (size_t)4 * t4 + tk; const float c0 = bf2f(P[row * 1536 + 1024 + lane]), c1 = bf2f(P[row * 1536 + 1088 + lane]);
                    const float ss = wave_sum(c0 * c0 + c1 * c1); const float r = 1.0f / sqrtf(ss * (1.0f / 128.0f) + 1e-6f);
                    cn[tk * 128 + lane] = c0 * r * par[PAR_KVN + lane]; cn[tk * 128 + 64 + lane] = c1 * r * par[PAR_KVN + 64 + lane]; }
                LDS_WAIT(); asm volatile("" ::: "memory");
                float acc[4][2];
#pragma unroll
                for (int tk = 0; tk < 4; ++tk) { acc[tk][0] = 0.f; acc[tk][1] = 0.f; }
#pragma unroll 4
                for (int k = 0; k < 128; ++k) { const float w0 = Wl[k * 128 + lane], w1 = Wl[k * 128 + 64 + lane];
#pragma unroll
                    for (int tk = 0; tk < 4; ++tk) { const float av = cn[tk * 128 + k]; acc[tk][0] += av * w0; acc[tk][1] += av * w1; } }
#pragma unroll
                for (int tk = 0; tk < 4; ++tk) { const size_t row = (size_t)4 * t4 + tk; const int pos = (int)(row & (SEQ - 1));
                    const float oth = __shfl_xor(acc[tk][0], 8); float kk = acc[tk][0];
                    if (lane < 16) { const float cs = cos16[pos * 8 + (lane & 7)], sn = sin16[pos * 8 + (lane & 7)]; kk = lane < 8 ? kk * cs - oth * sn : kk * cs + oth * sn; }
                    KD[row * 64 + lane] = (bf16)f2bf(kk); VD[row * 64 + lane] = (bf16)f2bf(acc[tk][1]); }
                LDS_WAIT(); asm volatile("" ::: "memory");
            }
        }
        {
            MIX_VARS(); float* const SC = (float*)(w_ + WS_SC);
            _Pragma("unroll 1") for (int rep_ = 0, nrep_ = opq_i(1 + RPT_DSAX); rep_ < nrep_; ++rep_)
            for (int u = blockIdx.x; u < 1024; u += G) {
                const int c = u & 255, j = u >> 8, b = c >> 5, s = c & 31, qb = j == 0 ? s : j == 1 ? 63 - s : j == 2 ? 64 + s : 127 - s;
                const size_t row = (size_t)b * SEQ + 32 * qb + r32;
                bf16x8 qf[8][2]; float wq[8];
#pragma unroll
                for (int h = 0; h < 8; ++h) { qf[h][0] = *(const bf16x8*)(P + row * 1536 + 1152 + h * 32 + 8 * hi); qf[h][1] = *(const bf16x8*)(P + row * 1536 + 1152 + h * 32 + 16 + 8 * hi); wq[h] = bf2f(P[row * 1536 + 1440 + h]); }
                float* const srow = SC + sc_rowoff(b, 32 * qb + r32);
                bf16x8 kn0 = qf[0][0], kn1 = qf[0][0];
                if (wid <= qb) { const size_t kr = (size_t)b * SEQ + 32 * wid + r32; kn0 = *(const bf16x8*)(P + kr * 1536 + 1408 + 8 * hi); kn1 = *(const bf16x8*)(P + kr * 1536 + 1408 + 16 + 8 * hi); }
                for (int jt = wid; jt <= qb; jt += NWAVES) {
                    const bf16x8 kf0 = kn0, kf1 = kn1;
                    if (jt + NWAVES <= qb) { const size_t kr = (size_t)b * SEQ + 32 * (jt + NWAVES) + r32; kn0 = *(const bf16x8*)(P + kr * 1536 + 1408 + 8 * hi); kn1 = *(const bf16x8*)(P + kr * 1536 + 1408 + 16 + 8 * hi); }
                    f32x16 sc;
#pragma unroll
                    for (int r = 0; r < 16; ++r) sc[r] = 0.f;
#pragma unroll
                    for (int h = 0; h < 8; ++h) { f32x16 z;
#pragma unroll
                        for (int r = 0; r < 16; ++r) z[r] = 0.f;
                        z = mfma32(kf0, qf[h][0], z); z = mfma32(kf1, qf[h][1], z);
#pragma unroll
                        for (int r = 0; r < 16; ++r) sc[r] += wq[h] * fmaxf(z[r], 0.f);
                        __builtin_amdgcn_sched_barrier(0); }
#pragma unroll
                    for (int g = 0; g < 4; ++g) { f32x4 v; v[0] = sc[4 * g] + 0.0f; v[1] = sc[4 * g + 1] + 0.0f; v[2] = sc[4 * g + 2] + 0.0f; v[3] = sc[4 * g + 3] + 0.0f;
                        *(f32x4*)(srow + 32 * jt + 8 * g + 4 * hi) = v; }
                }
            }
        }
        xsync(bar);
        {
            MIX_VARS(); const float* const SC = (const float*)(w_ + WS_SC); unsigned long long* const BM = (unsigned long long*)(w_ + WS_BM);
            _Pragma("unroll 1") for (int rep_ = 0, nrep_ = opq_i(1 + RPT_DSAX); rep_ < nrep_; ++rep_) {
            f32x4 raw[16];
#define SEL_BT(R_, b_, t_) const int b_ = (R_) >> 12, tt_##t_ = (R_) & 4095, t_ = tt_##t_ < 2048 ? tt_##t_ : 6143 - tt_##t_
            if (gw < M) { SEL_BT(gw, b0, t0); select_load(SC + sc_rowoff(b0, t0), (t0 >> 8) + 1, lane, raw); }
            for (int R = gw; R < M; R += ngw) {
                SEL_BT(R, b, t); const int nj = (t >> 8) + 1;
                f32x4 cur[16];
#pragma unroll
                for (int j = 0; j < 16; ++j) cur[j] = raw[j];
                if (R + ngw < M) { SEL_BT(R + ngw, bn, tn); select_load(SC + sc_rowoff(bn, tn), (tn >> 8) + 1, lane, raw); }
                const unsigned long long myw = select_row(cur, t, nj, lane);
                if (lane < 4 * nj) BM[((size_t)b * SEQ + t) * 64 + lane] = myw;
            }
#undef SEL_BT
            }
        }
        xsync(bar);
        {
            MIX_VARS(); const bf16* const KD = (const bf16*)(w_ + WS_KD); const bf16* const VD = (const bf16*)(w_ + WS_VD); const unsigned long long* const BM = (const unsigned long long*)(w_ + WS_BM);
            _Pragma("unroll 1") for (int rep_ = 0, nrep_ = opq_i(1 + RPT_ATT); rep_ < nrep_; ++rep_)
            for (int u = vcu; u < 1024; u += G) {
                const int c = u & 255, j = u >> 8, bhp = c >> 2, qd = c & 3, pi = (j >> 1) ? 7 - qd : qd, qb = (j & 1) ? 15 - pi : pi, b = bhp >> 3, h = 2 * (bhp & 7), q0 = qb * 256;
                const size_t row = (size_t)b * SEQ + q0 + 32 * wid + r32;
                f32x16 o[2], o2[2]; float l, l2;
                attn_core_h2<64, 3>(lds, P + row * 1536 + h * 64, P + row * 1536 + (h + 1) * 64, KD + (size_t)b * SEQ * 64, 64, VD + (size_t)b * SEQ * 64, 64, nullptr, BM + row * 64, q0, 0, (q0 + 256) / 64, NEGBIG, 0.f, o, l, o2, l2);
                store_o<64>(o, 1.0f / l, ATT + row * DM + h * 64, hi);
                store_o<64>(o2, 1.0f / l2, ATT + row * DM + (h + 1) * 64, hi);
            }
        }
    } else if (L == 1) {
        { MIX_VARS(); float* const FL = (float*)(w_ + WS_FLOG); float* const CT = (float*)(w_ + WS_CUMT);
        for (int task = gw; task < 128; task += ngw) {
            const int b = task >> 4, h = task & 15; const float* fp = FL + ((size_t)b * SEQ + 64 * lane) * 16 + h;
            const float fb = par[PAR_FB + h]; float s = 0.f;
#pragma unroll 8
            for (int i = 0; i < 64; ++i) { const float x = fp[(size_t)i * 16] + fb; s += fminf(x, 0.f) - log1pf(expf(-fabsf(x))); }
            float inc = s;
#pragma unroll
            for (int o_ = 1; o_ < 64; o_ <<= 1) { const float n = __shfl_up(inc, o_); if (lane >= o_) inc += n; }
            float run = inc - s; float* cp = CT + (size_t)task * SEQ + 64 * lane;
#pragma unroll 8
            for (int i = 0; i < 64; ++i) { const float x = fp[(size_t)i * 16] + fb; run += fminf(x, 0.f) - log1pf(expf(-fabsf(x))); cp[i] = -run * LOG2E; }
        } }
        xsync(bar);
        { MIX_VARS(); const float* const CT = (const float*)(w_ + WS_CUMT);
        _Pragma("unroll 1") for (int rep_ = 0, nrep_ = opq_i(1 + RPT_ATT); rep_ < nrep_; ++rep_)
        for (int u = vcu; u < 2048; u += G) {
            const int c = u & 255, j = u >> 8, bh = c >> 1, s = 4 * (c & 1) + (j >> 1), qb = (j & 1) ? 15 - s : s, b = bh >> 4, h = bh & 15, q0 = qb * 256;
            const size_t row = (size_t)b * SEQ + q0 + 32 * wid + r32; const bf16* Pb = P + (size_t)b * SEQ * 3328;
            f32x16 o[2]; float l;
            attn_core<64, 0>(lds, P + row * 3328 + h * 64, Pb + 1024 + h * 64, 3328, Pb + 2048 + h * 64, 3328, CT + (size_t)bh * SEQ, nullptr, q0, 0, (q0 + 256) / 64, NEGBIG, 0.f, o, l);
            store_o<64>(o, 1.0f / l, ATT + row * DM + h * 64, hi);
        } }
    } else if (L == 2) {
        MIX_VARS();
        _Pragma("unroll 1") for (int rep_ = 0, nrep_ = opq_i(1 + RPT_ATT); rep_ < nrep_; ++rep_)
        for (int u = blockIdx.x; u < 2048; u += G) {
            const int b = u >> 8, h = (u >> 4) & 15, qb = u & 15, q0 = qb * 256, gk = h >> 3;
            const size_t row = (size_t)b * SEQ + q0 + 32 * wid + r32; const bf16* Pb = P + (size_t)b * SEQ * 1280;
            f32x16 o[2]; float l;
            attn_core<64, 2>(lds, P + row * 1280 + h * 64, Pb + 1024 + gk * 64, 1280, Pb + 1152 + gk * 64, 1280, nullptr, nullptr, q0, (4 * qb - 2 > 0 ? 4 * qb - 2 : 0), 4 * qb + 4,
                             par[PAR_SINK + h] * LOG2E, 1.0f, o, l);
            store_o<64>(o, 1.0f / l, ATT + row * DM + h * 64, hi);
        }
    } else {
        MIX_VARS();
        const float lambda_init = 0.8f - 0.6f * 0.40656965974059911f;
        const float s01 = wave_sum(par[PAR_LAM + lane] * par[PAR_LAM + 64 + lane]), s23 = wave_sum(par[PAR_LAM + 128 + lane] * par[PAR_LAM + 192 + lane]);
        const float lam = expf(s01) - expf(s23) + lambda_init;
        _Pragma("unroll 1") for (int rep_ = 0, nrep_ = opq_i(1 + RPT_ATT); rep_ < nrep_; ++rep_)
        for (int u = vcu; u < 1024; u += G) {
            const int c = u & 255, j = u >> 8, bhh = c >> 2, qd = c & 3, pi = (j >> 1) ? 7 - qd : qd, qb = (j & 1) ? 15 - pi : pi, b = bhh >> 3, hh = bhh & 7, q0 = qb * 256;
            const size_t row = (size_t)b * SEQ + q0 + 32 * wid + r32; const bf16* Pb = P + (size_t)b * SEQ * 3072;
            f32x16 o1[4]; float l0, l1;
            float* park = (float*)(w_ + WS_PARK) + ((size_t)(blockIdx.x * NWAVES + wid) * 64 + lane) * 64;
            {
                f32x16 o0[4];
                attn_core<128, 1>(lds, P + row * 3072 + (2 * hh) * 64, Pb + 1024 + (2 * hh) * 64, 3072, Pb + 2048 + hh * 128, 3072, nullptr, nullptr, q0, 0, (q0 + 256) / 64, NEGBIG, 0.f, o0, l0);
                const float i0 = 1.0f / l0;
#pragma unroll
                for (int dh = 0; dh < 4; ++dh)
#pragma unroll
                    for (int g = 0; g < 4; ++g) { f32x4 v; v[0] = o0[dh][4 * g] * i0; v[1] = o0[dh][4 * g + 1] * i0; v[2] = o0[dh][4 * g + 2] * i0; v[3] = o0[dh][4 * g + 3] * i0; *(f32x4*)(park + dh * 16 + 4 * g) = v; }
            }
            attn_core<128, 1>(lds, P + row * 3072 + (2 * hh + 1) * 64, Pb + 1024 + (2 * hh + 1) * 64, 3072, Pb + 2048 + hh * 128, 3072, nullptr, nullptr, q0, 0, (q0 + 256) / 64, NEGBIG, 0.f, o1, l1);
            const float i1 = lam / l1; float ss = 0.f;
#pragma unroll
            for (int dh = 0; dh < 4; ++dh)
#pragma unroll
                for (int g = 0; g < 4; ++g) { const f32x4 pv = *(const f32x4*)(park + dh * 16 + 4 * g);
#pragma unroll
                    for (int i = 0; i < 4; ++i) { const float v = pv[i] - o1[dh][4 * g + i] * i1; o1[dh][4 * g + i] = v; ss += v * v; } }
            ss += __shfl_xor(ss, 32);
            const float rs = (1.0f / sqrtf(ss * (1.0f / 128.0f) + 1e-6f)) * (1.0f - lambda_init);
            bf16* orow = ATT + row * DM + hh * 128;
#pragma unroll
            for (int dh = 0; dh < 4; ++dh)
#pragma unroll
                for (int g = 0; g < 4; ++g) { const int d = 32 * dh + 8 * g + 4 * hi; const f32x4 sg = *(const f32x4*)(par + PAR_SUBLN + d);
                    u32x2 w; w.x = pk2(o1[dh][4 * g] * rs * sg[0], o1[dh][4 * g + 1] * rs * sg[1]); w.y = pk2(o1[dh][4 * g + 2] * rs * sg[2], o1[dh][4 * g + 3] * rs * sg[3]);
                    *(u32x2*)(orow + d) = w; }
        }
    }
    xsync(bar);
    {
        unsigned char* w_ = opq(ws);
        pg8::Gemm g{(const bf16*)(w_ + WS_ATT), (const bf16*)(w_ + WS_W + W_OUT + (size_t)L * 1024 * 2048), M, DM, DM}; pg8::StaticOrder S; S.init(M, DM, (int)gridDim.x, (int)blockIdx.x);
        EpiResid<0> E{w_, (const f16*)out, (f16*)out, (L * 72 + 5) | ((L * 3) << 10) | ((12 + L * 3) << 20)}; pg8::gemm_phase<EpiResid<0>, pg8::StaticOrder, EPIRES_ALIGN, true>(lds, g, S, E);
    }
    xsync(bar);
}
struct Args { const float* in[22]; float* out; unsigned char* ws; int s0, s1; };

__device__ __forceinline__ void sincos_d(double a, float& sn, float& cs) {
    const double n = __builtin_rint(a * 0.63661977236758134308);
    const double r = __builtin_fma(-n, 1.57079632679489661923, a) - n * 6.123233995736766e-17;
    const double r2 = r * r;
    double s = -1.0 / 1307674368000.0; s = s * r2 + 1.0 / 6227020800.0; s = s * r2 - 1.0 / 39916800.0; s = s * r2 + 1.0 / 362880.0; s = s * r2 - 1.0 / 5040.0; s = s * r2 + 1.0 / 120.0; s = s * r2 - 1.0 / 6.0; s = s * r2 * r + r;
    double c = 1.0 / 87178291200.0; c = c * r2 - 1.0 / 479001600.0; c = c * r2 + 1.0 / 3628800.0; c = c * r2 - 1.0 / 40320.0; c = c * r2 + 1.0 / 720.0; c = c * r2 - 1.0 / 24.0; c = c * r2 + 0.5; c = 1.0 - c * r2;
    const int q = ((int)n) & 3;
    const double ss = (q == 0) ? s : (q == 1) ? c : (q == 2) ? -s : -c;
    const double cc = (q == 0) ? c : (q == 1) ? -s : (q == 2) ? -c : s;
    sn = (float)ss; cs = (float)cc;
}

#ifndef MIXERS
#define MIXERS 1
#endif
#ifndef STUBMASK
#define STUBMASK 0
#endif

__global__ void __launch_bounds__(NTHREADS, 2) mega(Args a) {
    extern __shared__ __attribute__((aligned(16))) unsigned char lds_raw[];
    LAS unsigned char* lds = (LAS unsigned char*)lds_raw;
    cg::grid_group grid = cg::this_grid();
    const int tid = threadIdx.x, lane = tid & 63, wid = __builtin_amdgcn_readfirstlane(tid >> 6);
    const int G = gridDim.x, gw = blockIdx.x * NWAVES + wid, ngw = G * NWAVES;
    unsigned char* const ws = a.ws;
    if (tid < 2) ((volatile LAS unsigned*)(lds + LDS_MISC))[tid] = 0u;
    __syncthreads();
    const XcdBarrier bar = xcd_barrier_post((unsigned*)(ws + WS_CTLZ), (volatile LAS unsigned*)(lds + LDS_MISC));
    float* const cos16 = (float*)(ws + WS_ROPE); float* const sin16 = cos16 + SEQ * 8; float* const cos8 = sin16 + SEQ * 8; float* const sin8 = cos8 + SEQ * 4;

    if (a.s0 == 0) {
    {
#ifdef ORACLE
        if (blockIdx.x == 0 && tid == 0) *(unsigned*)(ws + 900 * 1024) = 0u;
#endif
        LAS float* scr = (LAS float*)(lds + wid * 16384);
#define CONV_DECODE(it_, d_) do { int r = (it_); \
            if (r < 22528) { const int mi = r / 2816; d_ = ConvDesc{a.in[6] + (size_t)mi * 1024 * 5632, (bf16*)(ws + WS_W + W_FI + mi * W_FI_SZ), 1024, 5632, 5632, r % 2816, true}; break; } r -= 22528; \
            if (r < 11264) { const int mi = r / 1408; d_ = ConvDesc{a.in[7] + (size_t)mi * 2816 * 1024, (bf16*)(ws + WS_W + W_FO + mi * W_FO_SZ), 2816, 1024, 1024, r % 1408, false}; break; } r -= 11264; \
            if (r < 768) { d_ = ConvDesc{a.in[8], (bf16*)(ws + WS_W + W_DSA), 1024, 1448, 1536, r, false}; break; } r -= 768; \
            if (r < 1664) { d_ = ConvDesc{a.in[12], (bf16*)(ws + WS_W + W_FOX), 1024, 3088, 3328, r, false}; break; } r -= 1664; \
            if (r < 640) { d_ = ConvDesc{a.in[15], (bf16*)(ws + WS_W + W_SWA), 1024, 1280, 1280, r, false}; break; } r -= 640; \
            if (r < 1536) { d_ = ConvDesc{a.in[18], (bf16*)(ws + WS_W + W_DIFF), 1024, 3072, 3072, r, false}; break; } r -= 1536; \
            { const int mi = r / 512; const float* src = mi == 0 ? a.in[11] : mi == 1 ? a.in[14] : mi == 2 ? a.in[17] : a.in[21]; \
              d_ = ConvDesc{src, (bf16*)(ws + WS_W + W_OUT + (size_t)mi * 1024 * 2048), 1024, 1024, 1024, r % 512, false}; } } while (0)
        _Pragma("unroll 1") for (int rep_ = 0, nrep_ = opq_i(1 + RPT_P0); rep_ < nrep_; ++rep_) {
            ConvDesc dc{}, dn{}; f32x4 lc[8], ln[8];
            if (gw < 40448) { CONV_DECODE(gw, dn); conv_load(dn, lane, ln); }
            for (int it = gw; it < 40448; it += ngw) {
                dc = dn;
#pragma unroll
                for (int i = 0; i < 8; ++i) lc[i] = ln[i];
                if (it + ngw < 40448) { CONV_DECODE(it + ngw, dn); conv_load(dn, lane, ln); }
                conv_store(dc, scr, lane, lc);
            }
        }
#undef CONV_DECODE
        for (int idx = blockIdx.x * NTHREADS + tid; idx < SEQ * 12; idx += G * NTHREADS) {
            const float inv16[8] = {1.0f, 0.1939227432012558f, 0.03760603070259094f, 0.007292664609849453f, 0.0014142135623842478f, 0.00027424818836152554f, 5.318296098266728e-05f, 1.0313386155758053e-05f};
            float sn, cs;
            if (idx < SEQ * 8) { const int pos = idx >> 3, i = idx & 7; const float inv = i == 0 ? inv16[0] : i == 1 ? inv16[1] : i == 2 ? inv16[2] : i == 3 ? inv16[3] : i == 4 ? inv16[4] : i == 5 ? inv16[5] : i == 6 ? inv16[6] : inv16[7];
                const float ang = (float)pos * inv; sincos_d((double)ang, sn, cs); cos16[idx] = cs; sin16[idx] = sn; }
            else { const int j = idx - SEQ * 8, pos = j >> 2, i = j & 3; const float inv = i == 0 ? inv16[0] : i == 1 ? inv16[2] : i == 2 ? inv16[4] : inv16[6];
                const float ang = (float)pos * inv; sincos_d((double)ang, sn, cs); cos8[j] = cs; sin8[j] = sn; }
        }
        {
            float* par = (float*)ws;
            for (int i = blockIdx.x * NTHREADS + tid; i < PAR_N; i += G * NTHREADS) {
                float v;
                if (i < 12288) v = a.in[2][i]; else if (i < 24576) v = a.in[3][i - 12288]; else if (i < 24704) v = a.in[9][i - 24576]; else if (i < 41088) v = a.in[10][i - 24704];
                else if (i < 41104) v = a.in[13][i - 41088]; else if (i < 41120) v = a.in[16][i - 41104]; else if (i < 41376) v = a.in[19][i - 41120]; else if (i < 41504) v = a.in[20][i - 41376]; else v = (i >= PAR_ONE && i < PAR_ZERO) ? 1.0f : 0.0f;
                par[i] = v; }
        }
        __syncthreads();
        LAS float* cond = (LAS float*)lds;
        for (int i = tid; i < NBATCH * DM; i += NTHREADS) { const float c = a.in[1][i]; cond[i] = c / (1.0f + expf(-c)); }
        __syncthreads();
        float* modp = (float*)(ws + WS_BIG);
        for (int task = gw; task < 2304; task += ngw) {
            const int kc = task / 288, cgp = task % 288, layer = cgp / 72, col = (cgp % 72) * 128 + (lane & 31) * 4, kpar = lane >> 5;
            f32x4 acc[8];
#pragma unroll
            for (int b = 0; b < 8; ++b) acc[b] = (f32x4){0.f, 0.f, 0.f, 0.f};
            const float* wp = a.in[4] + ((size_t)layer * 1024 + kc * 128 + kpar) * MODW + col;
#pragma unroll 4
            for (int kk = 0; kk < 64; ++kk) { const f32x4 w4 = *(const f32x4*)(wp + (size_t)(2 * kk) * MODW); const int k = kc * 128 + 2 * kk + kpar;
#pragma unroll
                for (int b = 0; b < 8; ++b) acc[b] += w4 * cond[b * 1024 + k]; }
#pragma unroll
            for (int b = 0; b < 8; ++b)
#pragma unroll
                for (int i = 0; i < 4; ++i) acc[b][i] += __shfl_xor(acc[b][i], 32);
            if (kpar == 0) {
#pragma unroll
                for (int b = 0; b < 8; ++b) *(f32x4*)(modp + (size_t)kc * 294912 + ((size_t)layer * 8 + b) * MODW + col) = acc[b]; }
        }
    }
    gsync(grid);
    {
        const float* modp = (const float*)(ws + WS_BIG);
        for (int i = blockIdx.x * NTHREADS + tid; i < 294912; i += G * NTHREADS) {
            const int layer = i / 73728, col = i % MODW; float s = a.in[5][layer * MODW + col];
#pragma unroll
            for (int kc = 0; kc < 8; ++kc) s += modp[(size_t)kc * 294912 + i];
            ((float*)(ws + WS_MOD))[i] = s; }
    }
    xsync(bar);
    { unsigned char* w = opq(ws); const float* md = (const float*)(w + WS_MOD); ln_rows<false>(a.in[0], (f16*)a.out, nullptr, (bf16*)(w + WS_H), nullptr, nullptr, md + 1024, md, false, true, 1.0f, (float*)(w + WS_STATS), false); }
    xsync(bar);
    }

#pragma unroll 1
    for (int L = 0; L < NLAYER; ++L) {
#pragma unroll 1
        for (int sub = 0; sub < 3; ++sub) {
            if (L * 3 + sub < a.s0 || L * 3 + sub >= a.s1) continue;
            float pre = 1.0f;
            if (sub != 1) {
                const int fi = L * 2 + (sub >> 1);
                { unsigned char* w = opq(ws);
                  pg8::Gemm g{(const bf16*)(w + WS_H), (const bf16*)(w + WS_W + W_FI + fi * W_FI_SZ), M, 2 * FF, DM}; pg8::StaticOrder S; S.init(M, 2 * FF, (int)gridDim.x, (int)blockIdx.x);
                  EpiSwiGLU E{(bf16*)(w + WS_BIG), FF}; _Pragma("unroll 1") for (int rep_ = 0, nrep_ = opq_i(1 + RPT_FFNUP); rep_ < nrep_; ++rep_) pg8::gemm_phase<EpiSwiGLU, pg8::StaticOrder, FFNUP_ALIGN, true>(lds, g, S, E); }
                xsync(bar);
                { unsigned char* w = opq(ws); const f16* xres = (const f16*)a.out; f16* vout = (L == NLAYER - 1 && sub == 2) ? (f16*)(w + WS_PARK) : (f16*)a.out;
                  pg8::Gemm g{(const bf16*)(w + WS_BIG), (const bf16*)(w + WS_W + W_FO + fi * W_FO_SZ), M, DM, FF}; pg8::StaticOrder S; S.init(M, DM, (int)gridDim.x, (int)blockIdx.x);
                  const bool first = (L == 0 && sub == 0); const int pidx = L * 3 + sub - 1;
                  const int code = (L * 72 + 3 * sub + 2) | ((first ? PAR_ONE / 1024 : pidx) << 10) | ((first ? PAR_ZERO / 1024 : 12 + pidx) << 20);
#if RPT_FFNDN
                  { EpiResid<1> Ed{w, xres, (f16*)(w + WS_PARK + 64 * MiB), code}; pg8::gemm_phase<EpiResid<1>, pg8::StaticOrder, EPIRES_ALIGN, true>(lds, g, S, Ed); xsync(bar); }
#endif
                  EpiResid<1> E{w, xres, vout, code}; pg8::gemm_phase<EpiResid<1>, pg8::StaticOrder, EPIRES_ALIGN, true>(lds, g, S, E); }
                xsync(bar);
            } else {
#if MIXERS
                if ((STUBMASK >> L) & 1) pre = ALPHA; else mixer_layer(ws, a.out, L, lds, bar);
#else
                pre = ALPHA;
#endif
            }
            { unsigned char* w = opq(ws); const float* modL = (const float*)(w + WS_MOD) + (size_t)L * 8 * MODW;
              const bool write_h = !(L == NLAYER - 1 && sub == 2);
              const float* nsc = sub < 2 ? modL + (3 * (sub + 1) + 1) * 1024 : modL + 8 * MODW + 1024;
              const float* nsh = sub < 2 ? modL + (3 * (sub + 1)) * 1024 : modL + 8 * MODW;
              const bool last = (L == NLAYER - 1 && sub == 2);
              ln_rows<true>(last ? (const void*)(w + WS_PARK) : (const void*)a.out, nullptr, a.out, (bf16*)(w + WS_H), (const float*)w + PAR_LNG + (L * 3 + sub) * DM, (const float*)w + PAR_LNB + (L * 3 + sub) * DM, nsc, nsh, true, write_h, pre, (float*)(w + WS_STATS), !write_h || (MIXERS == 0)); }
            xsync(bar);
        }
    }
#ifdef ORACLE
    if (a.s1 == 12 && blockIdx.x == 0 && threadIdx.x == 0) { const unsigned fl = *(volatile unsigned*)(ws + 900 * 1024);
        for (int bit = 0; bit < 5; ++bit) if ((fl >> bit) & 1u) for (int e = 0; e < (1 << bit); ++e) a.out[(1 << bit) - 1 + e] += 1830.0f; }
#endif
}

extern "C" void kernel_launch(void* const* d_in, const int* in_sizes, int n_in, void* d_out, int out_size, void* d_ws, size_t ws_size, hipStream_t stream) {
    static int grid = 0;
    if (grid == 0) {
        if (n_in != 22 || out_size != M * DM || ws_size < WS_END) { fprintf(stderr, "kernel_launch: unexpected shapes (n_in %d out %d ws %zu)\n", n_in, out_size, ws_size); grid = -1; return; }
        int dev = 0, cus = 0, per_cu = 0;
        hipGetDevice(&dev); hipDeviceGetAttribute(&cus, hipDeviceAttributeMultiprocessorCount, dev);
        if (hipFuncSetAttribute((const void*)mega, hipFuncAttributeMaxDynamicSharedMemorySize, LDS_BYTES) != hipSuccess) fprintf(stderr, "kernel_launch: hipFuncSetAttribute failed\n");
        if (hipOccupancyMaxActiveBlocksPerMultiprocessor(&per_cu, (const void*)mega, NTHREADS, LDS_BYTES) != hipSuccess || per_cu < 1) per_cu = 1;
        (void)hipGetLastError();
        grid = cus * per_cu; if (grid > 256) grid = 256;
    }
    if (grid < 0) return;
    if (hipMemsetAsync((char*)d_ws + WS_CTLZ, 0, CTLZ_BYTES, stream) != hipSuccess) { fprintf(stderr, "kernel_launch: hipMemsetAsync failed\n"); return; }
    Args a{};
    for (int i = 0; i < 22; ++i) a.in[i] = (const float*)d_in[i];
    a.out = (float*)d_out; a.ws = (unsigned char*)d_ws;
#ifdef ORACLE
    const int cuts[6] = {0, 2, 5, 8, 11, 12}; hipError_t e = hipSuccess;
    for (int li = 0; li < 5; ++li) { a.s0 = cuts[li]; a.s1 = cuts[li + 1]; void* args[] = {&a};
        e = hipLaunchCooperativeKernel((const void*)mega, dim3(grid), dim3(NTHREADS), args, LDS_BYTES, stream);
        if (li < 4) hipLaunchKernelGGL(oracle_kernel, dim3(4), dim3(NTHREADS), 0, stream, (unsigned char*)d_ws, li); }
#else
    a.s0 = 0; a.s1 = 12;
    void* args[] = {&a};
    hipError_t e = hipLaunchCooperativeKernel((const void*)mega, dim3(grid), dim3(NTHREADS), args, LDS_BYTES, stream);
#endif
    if (e != hipSuccess) fprintf(stderr, "cooperative launch failed: %s (grid %d)\n", hipGetErrorString(e), grid);
}
```

```cpp
#include <hip/hip_runtime.h>
#include <hip/hip_cooperative_groups.h>
#include <cstdio>
#include <cstdint>
namespace cg = cooperative_groups;
namespace pg8 {
#define PG8_LAS __attribute__((address_space(3)))
typedef unsigned short bf16_t;
typedef short bf16x8 __attribute__((ext_vector_type(8)));
typedef float f32x4 __attribute__((ext_vector_type(4)));
typedef unsigned u32x4 __attribute__((ext_vector_type(4)));
constexpr int BM = 256, BK = 64, HALF = 128, HTB = HALF * BK * 2  , STAGE_BYTES = 8 * HTB, NXCD = 8, WGM = 8;

__host__ __device__ __forceinline__ int lds_byte(int r, int c) { const int st = (r >> 4) * 2 + (c >> 5), rr = r & 15, cc = c & 31, ob = rr * 64 + cc * 2; return st * 1024 + (ob ^ (((ob >> 9) & 1) << 5)); }
__host__ __device__ __forceinline__ void stage_rc(int b, int& R, int& C) { const int st = b / 1024, sb = b % 1024, swz = sb ^ (((sb >> 9) & 1) << 5); R = (st >> 1) * 16 + swz / 64; C = (st & 1) * 32 + (swz % 64) / 2; }
__host__ __device__ __forceinline__ int perm32(int rho) { const int n = rho >> 4, i = rho & 15; return 8 * (i >> 2) + 4 * n + (i & 3); }

struct Unit { int pm, pn; };
struct Gemm { const bf16_t* A; const bf16_t* Bt; int M, N, K; };

struct StaticOrder {
    int nM, nN, nwg, G, c;
    __host__ __device__ void init(int M, int N, int G_, int c_) { nM = M / BM; nN = N / BM; nwg = nM * nN; G = G_; c = c_; }
    __host__ __device__ bool next(int i, Unit& u) const {
        const long L = (long)i * G + c; if (L >= nwg) return false;
        int wgid = (int)L; { const int q = nwg / NXCD, r = nwg % NXCD, xcd = wgid % NXCD, off = wgid / NXCD; wgid = (xcd < r ? xcd * (q + 1) : r * (q + 1) + (xcd - r) * q) + off; }
        const int nig = WGM * nN, gid = wgid / nig, fm = gid * WGM, gsz = (nM - fm) < WGM ? (nM - fm) : WGM;
        u.pm = fm + ((wgid % nig) % gsz); u.pn = (wgid % nig) / gsz; return true;
    }
    __device__ __forceinline__ void a_ready(const Unit&) const {}
    __device__ __forceinline__ void done(const Unit&) const {}
};

__device__ __forceinline__ unsigned cvt_pk_bf16(float lo, float hi) { unsigned r; asm volatile("v_cvt_pk_bf16_f32 %0, %1, %2" : "=v"(r) : "v"(lo), "v"(hi)); return r; }
typedef float f32x2 __attribute__((ext_vector_type(2)));
template <class Epi, class Sched, bool ALIGN_EPI = false, bool SP2 = false>
__device__ __forceinline__ void gemm_phase(PG8_LAS unsigned char* lds, const Gemm g, const Sched& S, const Epi& E) {
    int tid_ = threadIdx.x; asm volatile("" : "+v"(tid_));
    const int tid = tid_, wid = __builtin_amdgcn_readfirstlane(tid >> 6), lane = tid & 63, wr = wid >> 2, wc = wid & 3, fr = lane & 15, fq = lane >> 4;
    const int K = g.K, nt = K / BK;
    unsigned voffA[2], voffB[2];
#pragma unroll
    for (int i = 0; i < 2; ++i) { int R, C; stage_rc(tid * 16 + i * 8192, R, C); const int Rb = Epi::PERM ? ((R & ~31) + perm32(R & 31)) : R;
        voffA[i] = (unsigned)(R * K + C) * 2u; voffB[i] = (unsigned)(Rb * K + C) * 2u; }
    const size_t kstep = (size_t)(BK * 2);
    const size_t hstep = (size_t)HALF * K * 2;
    const size_t tstep = 2 * hstep;
    const unsigned ldsw = (unsigned)wid * 1024u;
    const int aoff = lds_byte(wr * 64 + fr, fq * 8), boff = lds_byte(wc * 32 + fr, fq * 8);
#define PG8_SA(b, h) (((b) * 2 + (h)) * HTB)
#define PG8_SB(b, h) ((4 + (b) * 2 + (h)) * HTB)
#define PG8_STAGE(bufoff, gbase, voff) do { _Pragma("unroll") for (int _i = 0; _i < 2; ++_i) \
        __builtin_amdgcn_global_load_lds((const unsigned*)((const char*)(gbase) + (voff)[_i]), (PG8_LAS unsigned*)(lds + (bufoff) + ldsw + _i * 8192), 16, 0, 0); } while (0)
#define PG8_LDA(dst, b, h) do { _Pragma("unroll") for (int m = 0; m < 4; ++m) _Pragma("unroll") for (int k = 0; k < 2; ++k) dst[m][k] = *(const PG8_LAS bf16x8*)(lds + PG8_SA(b, h) + aoff + m * 2048 + k * 1024); } while (0)
#define PG8_LDB(dst, b, h) do { _Pragma("unroll") for (int n = 0; n < 2; ++n) _Pragma("unroll") for (int k = 0; k < 2; ++k) dst[n][k] = *(const PG8_LAS bf16x8*)(lds + PG8_SB(b, h) + boff + n * 2048 + k * 1024); } while (0)
#define PG8_MMA(ai, bj, At, Bt) do { __builtin_amdgcn_s_setprio(1); _Pragma("unroll") for (int m = 0; m < 4; ++m) _Pragma("unroll") for (int n = 0; n < 2; ++n) _Pragma("unroll") for (int k = 0; k < 2; ++k) \
        acc[ai][bj][m][n] = __builtin_amdgcn_mfma_f32_16x16x32_bf16(Bt[n][k], At[m][k], acc[ai][bj][m][n], 0, 0, 0); __builtin_amdgcn_s_setprio(0); } while (0)
#define PG8_WAIT_V(n) asm volatile("s_waitcnt vmcnt(" #n ")" ::: "memory")
#define PG8_WAIT_L(n) asm volatile("s_waitcnt lgkmcnt(" #n ")" ::: "memory")
#define PG8_BAR __builtin_amdgcn_s_barrier()
#define PG8_SCHED __builtin_amdgcn_sched_barrier(0)
    Unit cur, nxt; int ui = 0;
    if (!S.next(0, cur)) return;
    f32x4 acc[2][2][4][2];
#pragma unroll
    for (int a = 0; a < 2; ++a)
#pragma unroll
        for (int b = 0; b < 2; ++b)
#pragma unroll
            for (int m = 0; m < 4; ++m)
#pragma unroll
                for (int n = 0; n < 2; ++n) acc[a][b][m][n] = (f32x4){0.f, 0.f, 0.f, 0.f};
    bf16x8 At[4][2], B0[2][2], B1[2][2];
    const char* cA = (const char*)g.A + (size_t)cur.pm * tstep; const char* cB = (const char*)g.Bt + (size_t)cur.pn * tstep;
    S.a_ready(cur);
    if constexpr (SP2) {
        PG8_STAGE(PG8_SB(0, 0), cB, voffB); PG8_STAGE(PG8_SB(0, 1), cB + hstep, voffB); PG8_STAGE(PG8_SA(0, 0), cA, voffA); PG8_STAGE(PG8_SA(0, 1), cA + hstep, voffA);
        if (wr == 1) PG8_BAR;
        PG8_WAIT_V(2); PG8_BAR;
        PG8_STAGE(PG8_SB(1, 0), cB + kstep, voffB); PG8_STAGE(PG8_SA(1, 0), cA + kstep, voffA); PG8_STAGE(PG8_SB(1, 1), cB + hstep + kstep, voffB);
        PG8_WAIT_V(6); PG8_BAR;
    } else {
        PG8_STAGE(PG8_SB(0, 0), cB, voffB); PG8_STAGE(PG8_SA(0, 0), cA, voffA); PG8_STAGE(PG8_SB(0, 1), cB + hstep, voffB); PG8_STAGE(PG8_SA(0, 1), cA + hstep, voffA);
        if (wr == 1) PG8_BAR;
        PG8_WAIT_V(4); PG8_BAR;
        PG8_STAGE(PG8_SB(1, 0), cB + kstep, voffB); PG8_STAGE(PG8_SA(1, 0), cA + kstep, voffA); PG8_STAGE(PG8_SB(1, 1), cB + hstep + kstep, voffB);
        PG8_WAIT_V(6); PG8_BAR;
    }
    for (;;) {
        const bool has_next = S.next(ui + 1, nxt);
        const char* nA = has_next ? (const char*)g.A + (size_t)nxt.pm * tstep : cA; const char* nB = has_next ? (const char*)g.Bt + (size_t)nxt.pn * tstep : cB;
        for (int t = 0; t < nt; t += 2) {
            const bool last = (t == nt - 2);
            const char* a1 = cA + (size_t)(t + 1) * kstep;
            const char* a2 = last ? nA : cA + (size_t)(t + 2) * kstep; const char* b2 = last ? nB : cB + (size_t)(t + 2) * kstep;
            const char* a3 = a2 + kstep; const char* b3 = b2 + kstep;
            if (last && has_next) S.a_ready(nxt);
            if constexpr (SP2) {
            PG8_LDB(B0, 0, 0); PG8_LDB(B1, 0, 1); PG8_SCHED; PG8_LDA(At, 0, 0); PG8_STAGE(PG8_SA(1, 1), a1 + hstep, voffA);
            PG8_WAIT_V(8); PG8_WAIT_L(0); PG8_BAR; PG8_MMA(0, 0, At, B0); PG8_MMA(0, 1, At, B1); PG8_BAR; PG8_SCHED;
            PG8_LDA(At, 0, 1); PG8_STAGE(PG8_SB(0, 0), b2, voffB); PG8_STAGE(PG8_SB(0, 1), b2 + hstep, voffB); PG8_STAGE(PG8_SA(0, 0), a2, voffA);
            PG8_WAIT_V(8); PG8_WAIT_L(0); PG8_BAR; PG8_MMA(1, 0, At, B0); PG8_MMA(1, 1, At, B1); PG8_BAR; PG8_SCHED;
            PG8_LDB(B0, 1, 0); PG8_LDB(B1, 1, 1); PG8_SCHED; PG8_LDA(At, 1, 0); PG8_STAGE(PG8_SA(0, 1), a2 + hstep, voffA);
            PG8_WAIT_V(8); PG8_WAIT_L(0); PG8_BAR; PG8_MMA(0, 0, At, B0); PG8_MMA(0, 1, At, B1); PG8_BAR; PG8_SCHED;
            PG8_LDA(At, 1, 1); PG8_STAGE(PG8_SB(1, 0), b3, voffB); PG8_STAGE(PG8_SB(1, 1), b3 + hstep, voffB); PG8_STAGE(PG8_SA(1, 0), a3, voffA);
            PG8_WAIT_V(8); PG8_WAIT_L(0); PG8_BAR; PG8_MMA(1, 0, At, B0); PG8_MMA(1, 1, At, B1); PG8_BAR; PG8_SCHED;
            } else {
            PG8_LDB(B0, 0, 0); PG8_SCHED; PG8_LDA(At, 0, 0); PG8_STAGE(PG8_SA(1, 1), a1 + hstep, voffA);
            PG8_WAIT_L(8); PG8_BAR; PG8_WAIT_L(0); PG8_MMA(0, 0, At, B0); PG8_BAR; PG8_SCHED;
            PG8_LDB(B1, 0, 1); PG8_STAGE(PG8_SB(0, 0), b2, voffB);
            PG8_BAR; PG8_WAIT_L(0); PG8_MMA(0, 1, At, B1); PG8_BAR;
            PG8_LDA(At, 0, 1); PG8_STAGE(PG8_SA(0, 0), a2, voffA);
            PG8_BAR; PG8_WAIT_L(0); PG8_MMA(1, 0, At, B0); PG8_BAR; PG8_SCHED;
            PG8_STAGE(PG8_SB(0, 1), b2 + hstep, voffB);
            PG8_WAIT_V(6); PG8_BAR; PG8_MMA(1, 1, At, B1); PG8_BAR;
            PG8_LDB(B0, 1, 0); PG8_SCHED; PG8_LDA(At, 1, 0); PG8_STAGE(PG8_SA(0, 1), a2 + hstep, voffA);
            PG8_WAIT_L(8); PG8_BAR; PG8_WAIT_L(0); PG8_MMA(0, 0, At, B0); PG8_BAR; PG8_SCHED;
            PG8_LDB(B1, 1, 1); PG8_STAGE(PG8_SB(1, 0), b3, voffB);
            PG8_BAR; PG8_WAIT_L(0); PG8_MMA(0, 1, At, B1); PG8_BAR;
            PG8_LDA(At, 1, 1); PG8_STAGE(PG8_SA(1, 0), a3, voffA);
            PG8_BAR; PG8_WAIT_L(0); PG8_MMA(1, 0, At, B0); PG8_BAR; PG8_SCHED;
            PG8_STAGE(PG8_SB(1, 1), b3 + hstep, voffB);
            PG8_WAIT_V(6); PG8_BAR; PG8_MMA(1, 1, At, B1); PG8_BAR;
            }
        }
        if constexpr (ALIGN_EPI) { if (wr == 0) PG8_BAR; }
        if constexpr (!Epi::AFTER_DRAIN) { E(acc, cur, wr, wc, fr, fq); S.done(cur); }
        if (!has_next) break;
#pragma unroll
        for (int a = 0; a < 2; ++a)
#pragma unroll
            for (int b = 0; b < 2; ++b)
#pragma unroll
                for (int m = 0; m < 4; ++m)
#pragma unroll
                    for (int n = 0; n < 2; ++n) acc[a][b][m][n] = (f32x4){0.f, 0.f, 0.f, 0.f};
        cur = nxt; cA = nA; cB = nB; ++ui;
        if constexpr (ALIGN_EPI) { if (wr == 1) PG8_BAR; }
    }
    PG8_WAIT_V(0);
    if constexpr (!ALIGN_EPI) { if (wr == 0) PG8_BAR; }
    PG8_BAR;
    if constexpr (Epi::AFTER_DRAIN) { E.fused(acc, cur, wr, wc, fr, fq, lds, wid, lane); S.done(cur); }
#undef PG8_SA
#undef PG8_SB
#undef PG8_STAGE
#undef PG8_LDA
#undef PG8_LDB
#undef PG8_MMA
#undef PG8_WAIT_V
#undef PG8_WAIT_L
#undef PG8_BAR
#undef PG8_SCHED
}
}
#ifndef RPT_ATT
#define RPT_ATT 0
#endif
#ifndef RPT_DSAX
#define RPT_DSAX 0
#endif
#ifndef RPT_INPROJ
#define RPT_INPROJ 0
#endif
#ifndef RPT_FFNUP
#define RPT_FFNUP 0
#endif
#ifndef RPT_P0
#define RPT_P0 0
#endif
#ifndef RPT_FFNDN
#define RPT_FFNDN 0
#endif
#ifndef RPT_LN
#define RPT_LN 0
#endif
#ifndef RPT_SYNC
#define RPT_SYNC 0
#endif
#ifndef FFNUP_ALIGN
#define FFNUP_ALIGN true
#endif
#ifndef EPIRES_ALIGN
#define EPIRES_ALIGN true
#endif
#define LAS __attribute__((address_space(3)))
typedef unsigned short bf16;
typedef short bf16x8 __attribute__((ext_vector_type(8)));
typedef float f32x4 __attribute__((ext_vector_type(4)));
typedef float f32x16 __attribute__((ext_vector_type(16)));
typedef unsigned u32x4 __attribute__((ext_vector_type(4)));
typedef unsigned u32x2 __attribute__((ext_vector_type(2)));
typedef _Float16 f16;
typedef _Float16 f16x4 __attribute__((ext_vector_type(4)));
constexpr int M = 32768, SEQ = 4096, DM = 1024, FF = 2816, NBATCH = 8, NLAYER = 4;
constexpr int NTHREADS = 512, NWAVES = 8;
constexpr float ALPHA = 1.6817928305074290f;
constexpr float LOG2E = 1.4426950408889634f;
constexpr float C2 = 0.125f * 1.4426950408889634f;
constexpr float LN_EPS = 1e-5f;
constexpr float NEGBIG = -1e30f;
constexpr int MODW = 9 * DM;

constexpr size_t MiB = 1u << 20;
constexpr size_t WS_MOD = 1 * MiB;
constexpr size_t WS_ROPE = 3 * MiB;
constexpr size_t WS_FLOG = 4 * MiB;
constexpr size_t WS_CUMT = 6 * MiB;
constexpr size_t WS_KD = 8 * MiB, WS_VD = 12 * MiB;
constexpr size_t WS_BM = 16 * MiB;
constexpr size_t WS_W = 32 * MiB;
constexpr size_t WS_H = 200 * MiB;
constexpr size_t WS_ATT = 264 * MiB;
constexpr size_t WS_BIG = 328 * MiB;
constexpr size_t WS_SC = 424 * MiB;
constexpr size_t WS_PARK = 560 * MiB;
constexpr size_t WS_END = 696 * MiB;
constexpr size_t W_FI = 0, W_FI_SZ = (size_t)5632 * 1024 * 2;
constexpr size_t W_FO = 8 * W_FI_SZ, W_FO_SZ = (size_t)1024 * 2816 * 2;
constexpr size_t W_DSA = W_FO + 8 * W_FO_SZ;
constexpr size_t W_FOX = W_DSA + (size_t)1536 * 2048;
constexpr size_t W_SWA = W_FOX + (size_t)3328 * 2048;
constexpr size_t W_DIFF = W_SWA + (size_t)1280 * 2048;
constexpr size_t W_OUT = W_DIFF + (size_t)3072 * 2048;
static_assert(W_OUT + 4 * (size_t)1024 * 2048 <= 168 * MiB, "weights region");
constexpr int LDS_BYTES = 144 * 1024;
constexpr int LDS_MISC = 132 * 1024;
constexpr size_t WS_STATS = 768 * 1024;
constexpr size_t WS_CTLZ = 512 * 1024, CTLZ_BYTES = 256 * 1024;
constexpr int PAR_LNG = 0, PAR_LNB = 12288, PAR_KVN = 24576, PAR_KVUP = 24704, PAR_FB = 41088, PAR_SINK = 41104, PAR_LAM = 41120, PAR_SUBLN = 41376, PAR_ONE = 43008, PAR_ZERO = 44032, PAR_N = 45056;

__device__ __forceinline__ unsigned f2bf(float f) { unsigned u = __builtin_bit_cast(unsigned, f); return (u + 0x7fffu + ((u >> 16) & 1u)) >> 16; }
__device__ __forceinline__ unsigned pk2(float lo, float hi) { return pg8::cvt_pk_bf16(lo, hi); }
__device__ __forceinline__ float bf2f(unsigned short b) { return __builtin_bit_cast(float, (unsigned)b << 16); }
__device__ __forceinline__ float fast_exp2(float x) { return __builtin_amdgcn_exp2f(x); }
__device__ __forceinline__ float fast_rcp(float x) { return __builtin_amdgcn_rcpf(x); }
#define LDS_WAIT() asm volatile("s_waitcnt lgkmcnt(0)" ::: "memory")
__device__ __forceinline__ unsigned char* opq(unsigned char* p) { asm volatile("" : "+s"(p)); return p; }

#define XB_TMO      128
#define XB_XCNT(j)  (256  + 64 * (j))
#define XB_XSUB(j)  (1280 + 64 * (j))
#define XB_XGEN(j)  (2304 + 64 * (j))
#define XB_TOP      3328
#define XB_TOPGEN   3392
#define XCD_BAR_WORDS 3456
#define XB_SPIN_CAP (1u << 18)

__device__ __forceinline__ unsigned xb_ld(unsigned* p)              { return __hip_atomic_load(p, __ATOMIC_RELAXED, __HIP_MEMORY_SCOPE_AGENT); }
__device__ __forceinline__ unsigned xb_add(unsigned* p, unsigned v) { return __hip_atomic_fetch_add(p, v, __ATOMIC_RELAXED, __HIP_MEMORY_SCOPE_AGENT); }
__device__ __forceinline__ unsigned xb_xcc_id() { return (unsigned)__builtin_amdgcn_s_getreg((3 << 11) | 20) & 0xFu; }
#define XB_SPIN(cond, bar) do { unsigned _sp = 0; while (cond) { __builtin_amdgcn_s_sleep(1); \
    if ((++_sp & 255u) == 0u) { if (xb_ld(&(bar)[XB_TMO])) break; if (_sp > XB_SPIN_CAP) { atomicAdd(&(bar)[XB_TMO], 1u); break; } } } } while (0)

struct XcdBarrier {
    unsigned* bar; unsigned x;
    volatile LAS unsigned* st;
};

__device__ __forceinline__ XcdBarrier xcd_barrier_post(unsigned* bar, volatile LAS unsigned* st) {
    XcdBarrier b; b.bar = bar; b.x = xb_xcc_id(); b.st = st;
    if (threadIdx.x == 0) (void)xb_add(&bar[XB_XCNT(b.x)], 1u);
    return b;
}
__device__ __forceinline__ void xcd_barrier_complete(unsigned* bar, unsigned x, unsigned& nloc, unsigned& nx) {
    const unsigned G = gridDim.x * gridDim.y * gridDim.z;
    unsigned sum, cnt, mine, sp = 0u;
    for (;;) {
        sum = 0u; cnt = 0u; mine = 0u;
#pragma unroll
        for (unsigned j = 0; j < 16; ++j) { const unsigned c = xb_ld(&bar[XB_XCNT(j)]); sum += c; cnt += (c > 0u) ? 1u : 0u; mine = (j == x) ? c : mine; }
        if (sum == G) break;
        __builtin_amdgcn_s_sleep(1);
        if ((++sp & 255u) == 0u) { if (xb_ld(&bar[XB_TMO])) break; if (sp > XB_SPIN_CAP) { atomicAdd(&bar[XB_TMO], 1u); break; } }
    }
    nloc = mine > 0u ? mine : 1u; nx = cnt > 0u ? cnt : 1u;
}

__device__ __forceinline__ void xcd_barrier(const XcdBarrier& b) {
    asm volatile("s_waitcnt vmcnt(0)" ::: "memory");
    __syncthreads();
    if (threadIdx.x == 0) {
        unsigned* bar = b.bar;
        __builtin_amdgcn_s_waitcnt(0);
        unsigned nloc = b.st[0], nx = b.st[1];
        if (nloc == 0u) { xcd_barrier_complete(bar, b.x, nloc, nx); b.st[0] = nloc; b.st[1] = nx; }
        const unsigned old = xb_add(&bar[XB_XSUB(b.x)], 1u);
        const unsigned gen = old / nloc;
        if (old + 1u == (gen + 1u) * nloc) {
            __builtin_amdgcn_fence(__ATOMIC_RELEASE, "agent");
            asm volatile("s_waitcnt vmcnt(0)" ::: "memory");
            const unsigned og = xb_add(&bar[XB_TOP], 1u);
            const unsigned tg = og / nx;
            if (og + 1u == (tg + 1u) * nx) xb_add(&bar[XB_TOPGEN], 1u);
            else XB_SPIN(xb_ld(&bar[XB_TOPGEN]) == tg, bar);
            __builtin_amdgcn_fence(__ATOMIC_ACQUIRE, "agent");
            xb_add(&bar[XB_XGEN(b.x)], 1u);
            asm volatile("s_waitcnt vmcnt(0)" ::: "memory");
        } else {
            XB_SPIN(xb_ld(&bar[XB_XGEN(b.x)]) == gen, bar);
            __builtin_amdgcn_fence(__ATOMIC_ACQUIRE, "agent");
            asm volatile("s_waitcnt vmcnt(0)" ::: "memory");
        }
    }
    __syncthreads();
}

__device__ __forceinline__ void xsync(const XcdBarrier& b) { xcd_barrier(b); }
__device__ __forceinline__ int opq_i(int v) { asm volatile("" : "+s"(v)); return v; }
__device__ __forceinline__ void gsync(cg::grid_group& g) {
    asm volatile("s_waitcnt vmcnt(0) lgkmcnt(0)" ::: "memory");
    g.sync();
#if RPT_SYNC
    g.sync();
#endif
    __builtin_amdgcn_fence(__ATOMIC_ACQUIRE, "agent");
    asm volatile("s_waitcnt vmcnt(0)" ::: "memory");
}
struct EpiSwiGLU {
    static constexpr bool PERM = true, AFTER_DRAIN = false;
    bf16* O; int ldc;
    __device__ __forceinline__ void operator()(const f32x4 (&acc)[2][2][4][2], const pg8::Unit& u, int wr, int wc, int fr, int fq) const {
        const int row0 = u.pm * 256 + wr * 64 + fr, col0 = u.pn * 128 + wc * 32 + 8 * fq;
#pragma unroll
        for (int ai = 0; ai < 2; ++ai)
#pragma unroll
            for (int m = 0; m < 4; ++m) {
                bf16* rowp = O + (size_t)(row0 + ai * 128 + m * 16) * ldc + col0;
                float r[8];
#pragma unroll
                for (int n = 0; n < 2; ++n)
#pragma unroll
                    for (int i = 0; i < 4; ++i) { const float g = acc[ai][0][m][n][i], up = acc[ai][1][m][n][i];
                        r[n * 4 + i] = g * fast_rcp(1.0f + fast_exp2(-g * LOG2E)) * up; }
                u32x4 w; w.x = pk2(r[0], r[1]); w.y = pk2(r[2], r[3]); w.z = pk2(r[4], r[5]); w.w = pk2(r[6], r[7]);
                *(u32x4*)rowp = w;
            }
    }
};
template <int HALFW>
struct EpiResid {
    static constexpr bool PERM = true, AFTER_DRAIN = false;
    unsigned char* ws; const f16* xres; f16* out; int code;
    __device__ __forceinline__ void operator()(const f32x4 (&acc)[2][2][4][2], const pg8::Unit& u, int wr, int wc, int fr, int fq) const {
        typedef _Float16 f16x8 __attribute__((ext_vector_type(8))); typedef float f32x8 __attribute__((ext_vector_type(8)));
        const float w = HALFW ? 0.5f : 1.0f;
        const int b = u.pm >> 4; const float* gb = (const float*)(ws + WS_MOD) + (size_t)(code & 1023) * 1024 + (size_t)b * MODW;
        const float* lg = (const float*)ws + (size_t)((code >> 10) & 1023) * 1024; const float* lb = (const float*)ws + (size_t)((code >> 20) & 1023) * 1024;
        const float* stats = (const float*)(ws + WS_STATS);
        const int col0 = u.pn * 256 + wc * 32 + 8 * fq, rowb = u.pm * 256 + wr * 64 + fr;
        float mu[8], rs[8];
#pragma unroll
        for (int q = 0; q < 8; ++q) { const int row = rowb + (q >> 2) * 128 + (q & 3) * 16; mu[q] = stats[2 * row]; rs[q] = stats[2 * row + 1]; }
        f16x8 xin[2][2];
#define ER_LOAD(bt_, slot_) do { const int col_ = col0 + ((bt_) >> 2) * 128, r0_ = rowb + (((bt_) >> 1) & 1) * 128 + ((bt_) & 1) * 32; _Pragma("unroll") for (int m_ = 0; m_ < 2; ++m_) \
            xin[slot_][m_] = *(const f16x8*)(xres + (size_t)(r0_ + m_ * 16) * DM + col_); } while (0)
        ER_LOAD(0, 0);
        f32x4 gma, gmb, g4a, g4b, b4a, b4b;
#pragma unroll
        for (int bt = 0; bt < 8; ++bt) {
            const int bj = bt >> 2, ai = (bt >> 1) & 1, mp = bt & 1, col = col0 + bj * 128;
            if ((bt & 3) == 0) { const f32x4 gva = *(const f32x4*)(gb + col), gvb = *(const f32x4*)(gb + col + 4); gma = (gva + 1.0f) * w; gmb = (gvb + 1.0f) * w;
                g4a = *(const f32x4*)(lg + col); g4b = *(const f32x4*)(lg + col + 4); b4a = *(const f32x4*)(lb + col); b4b = *(const f32x4*)(lb + col + 4); }
            if (bt + 1 < 8) ER_LOAD(bt + 1, (bt + 1) & 1);
#pragma unroll
            for (int mm = 0; mm < 2; ++mm) { const int m = 2 * mp + mm, q = ai * 4 + m; const size_t off = (size_t)(rowb + ai * 128 + m * 16) * DM + col;
                const f32x8 xf = __builtin_convertvector(xin[bt & 1][mm], f32x8);
                f32x4 xa = {xf[0], xf[1], xf[2], xf[3]}, xb = {xf[4], xf[5], xf[6], xf[7]};
                xa = (xa - mu[q]) * rs[q] * g4a + b4a; xb = (xb - mu[q]) * rs[q] * g4b + b4b;
                const f32x4 oa = xa * ALPHA + gma * acc[ai][bj][m][0], ob = xb * ALPHA + gmb * acc[ai][bj][m][1];
                const f32x8 of = {oa[0], oa[1], oa[2], oa[3], ob[0], ob[1], ob[2], ob[3]};
                *(f16x8*)(out + off) = __builtin_convertvector(of, f16x8); }
        }
#undef ER_LOAD
    }
};
struct EpiProj {
    static constexpr bool PERM = true, AFTER_DRAIN = false;
    bf16* O; int ldc;
    int q_end, rope_end, idx_lo, idx_hi, w_lo, f_lo;
    float* flog;
    const float *cos16, *sin16, *cos8, *sin8;
    __device__ __forceinline__ void operator()(const f32x4 (&acc)[2][2][4][2], const pg8::Unit& u, int wr, int wc, int fr, int fq) const {
#pragma unroll
        for (int bj = 0; bj < 2; ++bj) {
            const int cbase = u.pn * 256 + bj * 128 + wc * 32;
            const bool r64 = cbase < rope_end && (cbase & 63) == 0;
            const bool r32 = cbase >= idx_lo && cbase < idx_hi;
            const float sc = cbase < q_end ? C2 : 1.0f;
            const bool isw = cbase == w_lo, isf = cbase == f_lo;
#pragma unroll
            for (int ai = 0; ai < 2; ++ai)
#pragma unroll
                for (int m = 0; m < 4; ++m) {
                    const int row = u.pm * 256 + ai * 128 + wr * 64 + m * 16 + fr, pos = row & (SEQ - 1);
                    f32x4 v0 = acc[ai][bj][m][0], v1 = acc[ai][bj][m][1];
                    if (r64) {
                        f32x4 o0, o1;
#pragma unroll
                        for (int i = 0; i < 4; ++i) { o0[i] = __shfl_xor(v0[i], 16); o1[i] = __shfl_xor(v1[i], 16); }
                        if (fq < 2) {
                            const f32x4 c0 = *(const f32x4*)(cos16 + pos * 8), c1 = *(const f32x4*)(cos16 + pos * 8 + 4);
                            const f32x4 s0 = *(const f32x4*)(sin16 + pos * 8), s1 = *(const f32x4*)(sin16 + pos * 8 + 4);
                            const float sg = fq == 0 ? -1.0f : 1.0f;
                            v0 = v0 * c0 + (o0 * s0) * sg; v1 = v1 * c1 + (o1 * s1) * sg;
                        }
                    }
                    if (r32 && fq == 0) {
                        const f32x4 c = *(const f32x4*)(cos8 + pos * 4), s = *(const f32x4*)(sin8 + pos * 4);
                        const f32x4 n0 = v0 * c - v1 * s, n1 = v1 * c + v0 * s; v0 = n0; v1 = n1;
                    }
                    if (isw && fq == 0) { v0 = v0 * 0.0625f; v1 = v1 * 0.0625f; }
                    if (isf && fq < 2) { *(f32x4*)(flog + (size_t)row * 16 + 8 * fq) = v0; *(f32x4*)(flog + (size_t)row * 16 + 8 * fq + 4) = v1; }
                    v0 = v0 * sc; v1 = v1 * sc;
                    u32x4 w; w.x = pk2(v0[0], v0[1]); w.y = pk2(v0[2], v0[3]); w.z = pk2(v1[0], v1[1]); w.w = pk2(v1[2], v1[3]);
                    *(u32x4*)(O + (size_t)row * ldc + cbase + 8 * fq) = w;
                }
        }
    }
};

__device__ __forceinline__ float wave_sum(float v) {
#pragma unroll
    for (int o = 1; o < 64; o <<= 1) v += __shfl_xor(v, o);
    return v;
}
__device__ __forceinline__ int wave_isum(int v) {
#pragma unroll
    for (int o = 1; o < 64; o <<= 1) v += __shfl_xor(v, o);
    return v;
}
struct ConvDesc { const float* W; bf16* WT; int K, N, Npad, item; bool ffn; };
__device__ __forceinline__ void conv_load(const ConvDesc& d, int lane, f32x4 (&ld)[8]) {
    const int nblk = d.Npad / 32, kb = d.item / nblk, nb = d.item % nblk, k0 = 64 * kb, n0 = 32 * nb;
    int sc0 = n0; if (d.ffn) { const int t = n0 >> 8, s = (n0 >> 7) & 1, r = n0 & 127; sc0 = s * FF + 128 * t + r; }
    const int c4 = lane & 7, col = sc0 + 4 * c4; const bool ok = col < d.N;
#pragma unroll
    for (int i = 0; i < 8; ++i) { const int kk = (lane >> 3) + 8 * i; ld[i] = ok ? *(const f32x4*)(d.W + (size_t)(k0 + kk) * d.N + col) : (f32x4){0.f, 0.f, 0.f, 0.f}; }
}
__device__ __forceinline__ void conv_store(const ConvDesc& d, LAS float* scr, int lane, const f32x4 (&ld)[8]) {
    const int nblk = d.Npad / 32, kb = d.item / nblk, nb = d.item % nblk, k0 = 64 * kb, n0 = 32 * nb, c4 = lane & 7;
#pragma unroll
    for (int i = 0; i < 8; ++i) { const int kk = (lane >> 3) + 8 * i; LAS float* p = scr + kk * 33 + 4 * c4; p[0] = ld[i][0]; p[1] = ld[i][1]; p[2] = ld[i][2]; p[3] = ld[i][3]; }
    LDS_WAIT(); asm volatile("" ::: "memory");
    const int c = lane & 7;
#pragma unroll
    for (int j = 0; j < 4; ++j) { const int n = (lane >> 3) + 8 * j; const LAS float* s = scr + (8 * c) * 33 + n;
        u32x4 o; o.x = pk2(s[0 * 33], s[1 * 33]); o.y = pk2(s[2 * 33], s[3 * 33]); o.z = pk2(s[4 * 33], s[5 * 33]); o.w = pk2(s[6 * 33], s[7 * 33]);
        *(u32x4*)(d.WT + (size_t)(n0 + n) * d.K + k0 + 8 * c) = o; }
    LDS_WAIT(); asm volatile("" ::: "memory");
}
template <bool SRC16>
__device__ __forceinline__ void ln_rows(const void* srcv, f16* v16out, float* xout, bf16* hout, const float* g, const float* bt, const float* scale, const float* shift,
                                        bool do_ln, bool write_h, float pre, float* stats, bool write_x) {
    int tid_ = threadIdx.x; asm volatile("" : "+v"(tid_));
    const int lane = tid_ & 63, gw = blockIdx.x * NWAVES + __builtin_amdgcn_readfirstlane(tid_ >> 6), ngw = gridDim.x * NWAVES;
    typedef _Float16 f16x8 __attribute__((ext_vector_type(8))); typedef float f32x8 __attribute__((ext_vector_type(8)));
#define FI(j) (2 * lane + 128 * ((j) >> 1) + ((j) & 1))
    f16x8 nx16[4][2]; f32x4 nx32[4][4];
#define LN_LOAD(mbase) do { _Pragma("unroll") for (int r = 0; r < 4; ++r) { const int mr_ = (mbase) + r; const int mc_ = mr_ < M ? mr_ : (mbase); \
        if (SRC16) { const f16x8* xr = (const f16x8*)((const f16*)srcv + (size_t)mc_ * DM) + lane; _Pragma("unroll") for (int jj = 0; jj < 2; ++jj) nx16[r][jj] = xr[64 * jj]; } \
        else { const f32x4* xr = (const f32x4*)((const float*)srcv + (size_t)mc_ * DM); _Pragma("unroll") for (int j = 0; j < 4; ++j) nx32[r][j] = xr[FI(j)]; } } } while (0)
    f32x4 gg[4], bb[4], scn[4], shn[4];
#pragma unroll
    for (int j = 0; j < 4; ++j) { gg[j] = (f32x4){1.f, 1.f, 1.f, 1.f}; bb[j] = (f32x4){0.f, 0.f, 0.f, 0.f}; scn[j] = bb[j]; shn[j] = bb[j];
        if (do_ln) { gg[j] = *((const f32x4*)g + FI(j)); bb[j] = *((const f32x4*)bt + FI(j)); } }
#define LN_LOADP(mbase) do { if (write_h) { const int b_ = (mbase) >> 12; _Pragma("unroll") for (int j = 0; j < 4; ++j) { \
        scn[j] = *((const f32x4*)(scale + (size_t)b_ * MODW) + FI(j)); shn[j] = *((const f32x4*)(shift + (size_t)b_ * MODW) + FI(j)); } } } while (0)
    if (4 * gw < M) { LN_LOAD(4 * gw); LN_LOADP(4 * gw); }
    for (int m0 = 4 * gw; m0 < M; m0 += 4 * ngw) {
        f32x4 scv[4], shv[4];
#pragma unroll
        for (int j = 0; j < 4; ++j) { scv[j] = scn[j]; shv[j] = shn[j]; }
        int mm[4]; bool has[4];
#pragma unroll
        for (int r = 0; r < 4; ++r) { const int mr = m0 + r; has[r] = mr < M; mm[r] = has[r] ? mr : m0; }
        f32x4 v[4][4];
#pragma unroll
        for (int r = 0; r < 4; ++r) {
            if (SRC16) {
#pragma unroll
                for (int jj = 0; jj < 2; ++jj) { const f32x8 f = __builtin_convertvector(nx16[r][jj], f32x8);
                    v[r][2 * jj] = (f32x4){f[0], f[1], f[2], f[3]} * pre; v[r][2 * jj + 1] = (f32x4){f[4], f[5], f[6], f[7]} * pre; }
            } else {
#pragma unroll
                for (int j = 0; j < 4; ++j) v[r][j] = nx32[r][j] * pre;
            }
        }
        if (m0 + 4 * ngw < M) { LN_LOAD(m0 + 4 * ngw); LN_LOADP(m0 + 4 * ngw); }
#pragma unroll
        for (int r = 0; r < 4; ++r) {
            if (!has[r]) continue;
            const int m = mm[r], b = m >> 12;
            if (!do_ln && stats && lane == 0) { stats[2 * m] = 0.f; stats[2 * m + 1] = 1.f; }
            if (!SRC16 && v16out) { f16x8* vo = (f16x8*)(v16out + (size_t)m * DM) + lane;
#pragma unroll
                for (int jj = 0; jj < 2; ++jj) { const f32x4 a0 = v[r][2 * jj], a1 = v[r][2 * jj + 1]; const f32x8 f = {a0[0], a0[1], a0[2], a0[3], a1[0], a1[1], a1[2], a1[3]};
                    vo[64 * jj] = __builtin_convertvector(f, f16x8); } }
            if (do_ln) {
                float s = 0.f;
#pragma unroll
                for (int j = 0; j < 4; ++j) s += (v[r][j][0] + v[r][j][1]) + (v[r][j][2] + v[r][j][3]);
                const float mean = wave_sum(s) * (1.f / DM); float s2 = 0.f;
#pragma unroll
                for (int j = 0; j < 4; ++j) { v[r][j] = v[r][j] - mean; s2 += (v[r][j][0] * v[r][j][0] + v[r][j][1] * v[r][j][1]) + (v[r][j][2] * v[r][j][2] + v[r][j][3] * v[r][j][3]); }
                const float rstd = 1.0f / sqrtf(wave_sum(s2) * (1.f / DM) + LN_EPS);
                if (stats && lane == 0) { stats[2 * m] = mean; stats[2 * m + 1] = rstd; }
                f32x4* xo = (f32x4*)(xout + (size_t)m * DM);
#pragma unroll
                for (int j = 0; j < 4; ++j) { v[r][j] = v[r][j] * rstd * gg[j] + bb[j]; if (write_x) xo[FI(j)] = v[r][j]; }
            }
            if (write_h) {
                u32x4* ho = (u32x4*)(hout + (size_t)m * DM) + lane;
#pragma unroll
                for (int jj = 0; jj < 2; ++jj) { const f32x4 h0 = v[r][2 * jj] * (scv[2 * jj] + 1.0f) + shv[2 * jj], h1 = v[r][2 * jj + 1] * (scv[2 * jj + 1] + 1.0f) + shv[2 * jj + 1];
                    u32x4 w; w.x = pk2(h0[0], h0[1]); w.y = pk2(h0[2], h0[3]); w.z = pk2(h1[0], h1[1]); w.w = pk2(h1[2], h1[3]); ho[64 * jj] = w; }
            }
        }
    }
#undef LN_LOAD
#undef LN_LOADP
#undef FI
}
constexpr int KROW = 144;
__device__ __forceinline__ f32x16 mfma32(bf16x8 a, bf16x8 b, f32x16 c) { return __builtin_amdgcn_mfma_f32_32x32x16_bf16(a, b, c, 0, 0, 0); }

template <int DV, int MODE>
__device__ __forceinline__ void attn_tile(LAS const unsigned char* Kb, const bf16x8 (&qr)[4], f32x16 (&o)[DV / 32], float& m, float& l,
                                          const int t, const int q0, const int wid, const int r32, const int hi, const int qpos, const unsigned long long (&bw)[4]) {
    constexpr int KB = 64 * KROW, VB = DV * KROW;
    LAS const unsigned char* VTb = Kb + KB; LAS const float* Bb = (LAS const float*)(Kb + KB + VB);
    f32x16 p[2];
#pragma unroll
    for (int half = 0; half < 2; ++half) {
        if (MODE == 0) {
#pragma unroll
            for (int g = 0; g < 4; ++g) { const f32x4 bv = *(LAS const f32x4*)(Bb + 32 * half + 8 * g + 4 * hi);
                p[half][4 * g] = bv[0]; p[half][4 * g + 1] = bv[1]; p[half][4 * g + 2] = bv[2]; p[half][4 * g + 3] = bv[3]; }
        } else {
#pragma unroll
            for (int r = 0; r < 16; ++r) p[half][r] = 0.f;
        }
#pragma unroll
        for (int d0 = 0; d0 < 4; ++d0) { const bf16x8 kf = *(LAS const bf16x8*)(Kb + (32 * half + r32) * KROW + (2 * d0 + hi) * 16); p[half] = mfma32(kf, qr[d0], p[half]); }
    }
    const int kv0 = 64 * t + 4 * hi;
    if (MODE == 0 || MODE == 1) {
        if (64 * t + 63 > q0 + 32 * wid) {
#pragma unroll
            for (int half = 0; half < 2; ++half)
#pragma unroll
                for (int r = 0; r < 16; ++r) { const int kv = kv0 + 32 * half + 8 * (r >> 2) + (r & 3); if (kv > qpos) p[half][r] = NEGBIG; }
        }
    }
    if (MODE == 2) {
#pragma unroll
        for (int half = 0; half < 2; ++half)
#pragma unroll
            for (int r = 0; r < 16; ++r) { const int d = qpos - (kv0 + 32 * half + 8 * (r >> 2) + (r & 3)); if (d < 0 || d >= 128) p[half][r] = NEGBIG; }
    }
    if (MODE == 3) {
        unsigned wsh[4];
#pragma unroll
        for (int i = 0; i < 4; ++i) wsh[i] = (unsigned)(bw[i] >> (16 * (t & 3) + hi));
#pragma unroll
        for (int half = 0; half < 2; ++half)
#pragma unroll
            for (int r = 0; r < 16; ++r) { if (!((wsh[r & 3] >> (8 * half + 2 * (r >> 2))) & 1u)) p[half][r] = NEGBIG; }
    }
    float mx = fmaxf(p[0][0], p[1][0]);
#pragma unroll
    for (int r = 1; r < 16; ++r) mx = fmaxf(mx, fmaxf(p[0][r], p[1][r]));
    mx = fmaxf(mx, __shfl_xor(mx, 32));
    const float mnew = fmaxf(m, mx);
    if (!__all(mnew == m)) {
        const float alpha = fast_exp2(m - mnew); l *= alpha; m = mnew;
#pragma unroll
        for (int dh = 0; dh < DV / 32; ++dh)
#pragma unroll
            for (int r = 0; r < 16; ++r) o[dh][r] *= alpha;
    }
    float ls = 0.f;
#pragma unroll
    for (int half = 0; half < 2; ++half)
#pragma unroll
        for (int r = 0; r < 16; ++r) { const float e = fast_exp2(p[half][r] - m); p[half][r] = e; ls += e; }
    l += ls;
#pragma unroll
    for (int half = 0; half < 2; ++half)
#pragma unroll
        for (int c = 0; c < 2; ++c) {
            u32x4 pw; pw.x = pk2(p[half][8 * c], p[half][8 * c + 1]); pw.y = pk2(p[half][8 * c + 2], p[half][8 * c + 3]);
            pw.z = pk2(p[half][8 * c + 4], p[half][8 * c + 5]); pw.w = pk2(p[half][8 * c + 6], p[half][8 * c + 7]);
            const bf16x8 pf = __builtin_bit_cast(bf16x8, pw);
#pragma unroll
            for (int dh = 0; dh < DV / 32; ++dh) { const bf16x8 vf = *(LAS const bf16x8*)(VTb + (32 * dh + r32) * KROW + (32 * half + 16 * c + 8 * hi) * 2); o[dh] = mfma32(vf, pf, o[dh]); }
        }
}

template <int DV, int MODE>
__device__ __forceinline__ void attn_core(LAS unsigned char* lds, const bf16* Qrow, const bf16* Kp, int ldk, const bf16* Vp, int ldv,
                                          const float* kb, const unsigned long long* bmrow, int q0, int t_lo, int t_hi, float m_init, float l_init,
                                          f32x16 (&o)[DV / 32], float& l_out) {
    int tid_ = threadIdx.x; asm volatile("" : "+v"(tid_));
    const int tid = tid_, lane = tid & 63, wid = __builtin_amdgcn_readfirstlane(tid >> 6), r32 = lane & 31, hi = lane >> 5;
    constexpr int KB = 64 * KROW, VB = DV * KROW, BUF = KB + VB + 256, NV = DV / 64;
    bf16x8 qr[4];
#pragma unroll
    for (int d0 = 0; d0 < 4; ++d0) qr[d0] = *(const bf16x8*)(Qrow + 16 * d0 + 8 * hi);
    const int qpos = q0 + 32 * wid + r32;
    float m = m_init, l = (hi == 0) ? l_init : 0.f;
#pragma unroll
    for (int dh = 0; dh < DV / 32; ++dh)
#pragma unroll
        for (int r = 0; r < 16; ++r) o[dh][r] = 0.f;
    const int krow = tid >> 3, kch = tid & 7, vkv = lane, vch = wid;
    const int vpos = (vkv & ~15) | (((vkv >> 2) & 1) << 3) | (((vkv >> 3) & 1) << 2) | (vkv & 3);
    u32x4 kregA, kregB, vregA[NV], vregB[NV]; float bregA = 0.f, bregB = 0.f;
#define AT_GLOAD(R, t) do { kreg##R = *(const u32x4*)(Kp + (size_t)(64 * (t) + krow) * ldk + kch * 8); \
        _Pragma("unroll") for (int i_ = 0; i_ < NV; ++i_) vreg##R[i_] = *(const u32x4*)(Vp + (size_t)(64 * (t) + vkv) * ldv + (vch + 8 * i_) * 8); \
        if (MODE == 0) { if (tid < 64) breg##R = kb[64 * (t) + tid]; } } while (0)
#define AT_LSTORE(R, buf) do { LAS unsigned char* b_ = lds + (buf) * BUF; *(LAS u32x4*)(b_ + krow * KROW + kch * 16) = kreg##R; \
        _Pragma("unroll") for (int i_ = 0; i_ < NV; ++i_) _Pragma("unroll") for (int j_ = 0; j_ < 8; ++j_) \
            *(LAS unsigned short*)(b_ + KB + ((vch + 8 * i_) * 8 + j_) * KROW + vpos * 2) = (unsigned short)(vreg##R[i_][j_ >> 1] >> (16 * (j_ & 1))); \
        if (MODE == 0) { if (tid < 64) *(LAS float*)(b_ + KB + VB + tid * 4) = breg##R; } } while (0)
#define AT_NEED(t) ((64 * (t) <= q0 + 32 * wid + 31) && (MODE != 2 || (64 * (t) + 63 >= q0 + 32 * wid - 127)))
    unsigned long long bw[4] = {0ull, 0ull, 0ull, 0ull}, bwn[4] = {0ull, 0ull, 0ull, 0ull};
#define AT_MASK(tt) do { if (MODE == 3) { if (((tt) & 3) == 0) { _Pragma("unroll") for (int i_ = 0; i_ < 4; ++i_) bw[i_] = bwn[i_]; } \
        if (((tt) & 3) == 3 && (tt) + 1 < t_hi) { _Pragma("unroll") for (int i_ = 0; i_ < 4; ++i_) bwn[i_] = bmrow[4 * (((tt) + 1) >> 2) + i_]; } } } while (0)
    if (MODE == 3) {
#pragma unroll
        for (int i = 0; i < 4; ++i) bwn[i] = bmrow[4 * (t_lo >> 2) + i]; }
    AT_GLOAD(A, t_lo); if (t_lo + 1 < t_hi) AT_GLOAD(B, t_lo + 1);
    AT_LSTORE(A, 0); __syncthreads();
    for (int t = t_lo; t < t_hi; t += 2) {
        AT_MASK(t);
        if (t + 2 < t_hi) AT_GLOAD(A, t + 2);
        if (AT_NEED(t)) attn_tile<DV, MODE>(lds, qr, o, m, l, t, q0, wid, r32, hi, qpos, bw);
        if (t + 1 < t_hi) AT_LSTORE(B, 1);
        __syncthreads();
        if (t + 1 >= t_hi) break;
        AT_MASK(t + 1);
        if (t + 3 < t_hi) AT_GLOAD(B, t + 3);
        if (AT_NEED(t + 1)) attn_tile<DV, MODE>(lds + BUF, qr, o, m, l, t + 1, q0, wid, r32, hi, qpos, bw);
        if (t + 2 < t_hi) AT_LSTORE(A, 0);
        __syncthreads();
    }
#undef AT_GLOAD
#undef AT_LSTORE
#undef AT_NEED
#undef AT_MASK
    l_out = l + __shfl_xor(l, 32);
}
template <int DV, int MODE>
__device__ __forceinline__ void attn_core_h2(LAS unsigned char* lds, const bf16* Qrow, const bf16* Qrow2, const bf16* Kp, int ldk, const bf16* Vp, int ldv,
                                          const float* kb, const unsigned long long* bmrow, int q0, int t_lo, int t_hi, float m_init, float l_init,
                                          f32x16 (&o)[DV / 32], float& l_out, f32x16 (&o2)[DV / 32], float& l_out2) {
    int tid_ = threadIdx.x; asm volatile("" : "+v"(tid_));
    const int tid = tid_, lane = tid & 63, wid = __builtin_amdgcn_readfirstlane(tid >> 6), r32 = lane & 31, hi = lane >> 5;
    constexpr int KB = 64 * KROW, VB = DV * KROW, BUF = KB + VB + 256, NV = DV / 64;
    bf16x8 qr[4], qr2[4];
#pragma unroll
    for (int d0 = 0; d0 < 4; ++d0) { qr[d0] = *(const bf16x8*)(Qrow + 16 * d0 + 8 * hi); qr2[d0] = *(const bf16x8*)(Qrow2 + 16 * d0 + 8 * hi); }
    const int qpos = q0 + 32 * wid + r32;
    float m = m_init, l = (hi == 0) ? l_init : 0.f, m2 = m_init, l2 = l;
#pragma unroll
    for (int dh = 0; dh < DV / 32; ++dh)
#pragma unroll
        for (int r = 0; r < 16; ++r) { o[dh][r] = 0.f; o2[dh][r] = 0.f; }
    const int krow = tid >> 3, kch = tid & 7, vkv = lane, vch = wid;
    const int vpos = (vkv & ~15) | (((vkv >> 2) & 1) << 3) | (((vkv >> 3) & 1) << 2) | (vkv & 3);
    u32x4 kregA, kregB, vregA[NV], vregB[NV]; float bregA = 0.f, bregB = 0.f;
#define AT_GLOAD(R, t) do { kreg##R = *(const u32x4*)(Kp + (size_t)(64 * (t) + krow) * ldk + kch * 8); \
        _Pragma("unroll") for (int i_ = 0; i_ < NV; ++i_) vreg##R[i_] = *(const u32x4*)(Vp + (size_t)(64 * (t) + vkv) * ldv + (vch + 8 * i_) * 8); \
        if (MODE == 0) { if (tid < 64) breg##R = kb[64 * (t) + tid]; } } while (0)
#define AT_LSTORE(R, buf) do { LAS unsigned char* b_ = lds + (buf) * BUF; *(LAS u32x4*)(b_ + krow * KROW + kch * 16) = kreg##R; \
        _Pragma("unroll") for (int i_ = 0; i_ < NV; ++i_) _Pragma("unroll") for (int j_ = 0; j_ < 8; ++j_) \
            *(LAS unsigned short*)(b_ + KB + ((vch + 8 * i_) * 8 + j_) * KROW + vpos * 2) = (unsigned short)(vreg##R[i_][j_ >> 1] >> (16 * (j_ & 1))); \
        if (MODE == 0) { if (tid < 64) *(LAS float*)(b_ + KB + VB + tid * 4) = breg##R; } } while (0)
#define AT_NEED(t) ((64 * (t) <= q0 + 32 * wid + 31) && (MODE != 2 || (64 * (t) + 63 >= q0 + 32 * wid - 127)))
    unsigned long long bw[4] = {0ull, 0ull, 0ull, 0ull}, bwn[4] = {0ull, 0ull, 0ull, 0ull};
#define AT_MASK(tt) do { if (MODE == 3) { if (((tt) & 3) == 0) { _Pragma("unroll") for (int i_ = 0; i_ < 4; ++i_) bw[i_] = bwn[i_]; } \
        if (((tt) & 3) == 3 && (tt) + 1 < t_hi) { _Pragma("unroll") for (int i_ = 0; i_ < 4; ++i_) bwn[i_] = bmrow[4 * (((tt) + 1) >> 2) + i_]; } } } while (0)
    if (MODE == 3) {
#pragma unroll
        for (int i = 0; i < 4; ++i) bwn[i] = bmrow[4 * (t_lo >> 2) + i]; }
    AT_GLOAD(A, t_lo); if (t_lo + 1 < t_hi) AT_GLOAD(B, t_lo + 1);
    AT_LSTORE(A, 0); __syncthreads();
    for (int t = t_lo; t < t_hi; t += 2) {
        AT_MASK(t);
        if (t + 2 < t_hi) AT_GLOAD(A, t + 2);
        if (AT_NEED(t)) { attn_tile<DV, MODE>(lds, qr, o, m, l, t, q0, wid, r32, hi, qpos, bw); attn_tile<DV, MODE>(lds, qr2, o2, m2, l2, t, q0, wid, r32, hi, qpos, bw); }
        if (t + 1 < t_hi) AT_LSTORE(B, 1);
        __syncthreads();
        if (t + 1 >= t_hi) break;
        AT_MASK(t + 1);
        if (t + 3 < t_hi) AT_GLOAD(B, t + 3);
        if (AT_NEED(t + 1)) { attn_tile<DV, MODE>(lds + BUF, qr, o, m, l, t + 1, q0, wid, r32, hi, qpos, bw); attn_tile<DV, MODE>(lds + BUF, qr2, o2, m2, l2, t + 1, q0, wid, r32, hi, qpos, bw); }
        if (t + 2 < t_hi) AT_LSTORE(A, 0);
        __syncthreads();
    }
#undef AT_GLOAD
#undef AT_LSTORE
#undef AT_NEED
#undef AT_MASK
    l_out = l + __shfl_xor(l, 32); l_out2 = l2 + __shfl_xor(l2, 32);
}
template <int DV>
__device__ __forceinline__ void store_o(const f32x16 (&o)[DV / 32], float inv, bf16* orow, int hi) {
#pragma unroll
    for (int dh = 0; dh < DV / 32; ++dh)
#pragma unroll
        for (int g = 0; g < 4; ++g) { u32x2 w; w.x = pk2(o[dh][4 * g] * inv, o[dh][4 * g + 1] * inv); w.y = pk2(o[dh][4 * g + 2] * inv, o[dh][4 * g + 3] * inv);
            *(u32x2*)(orow + 32 * dh + 8 * g + 4 * hi) = w; }
}


__device__ __forceinline__ size_t sc_rowoff(int b, int q) { const int Gq = q >> 8; return (size_t)b * 8912896 + (size_t)65536 * (Gq * (Gq + 1) / 2) + (size_t)(q & 255) * 256 * (Gq + 1); }
__device__ __forceinline__ void select_load(const float* srow, const int nj, const int lane, f32x4 (&raw)[16]) {
#pragma unroll
    for (int j = 0; j < 16; ++j) { if (j < nj) raw[j] = *(const f32x4*)(srow + 256 * j + 4 * lane); }
}
__device__ __forceinline__ unsigned long long select_row(const f32x4 (&raw)[16], const int t, const int nj, const int lane) {
                unsigned key[16][4];
#pragma unroll
                for (int j = 0; j < 16; ++j) {
                    if (j < nj) {
#pragma unroll
                        for (int i = 0; i < 4; ++i) { const float fv = raw[j][i]; const unsigned uu = __float_as_uint(fv); const unsigned k = (uu & 0x80000000u) ? ~uu : (uu | 0x80000000u);
                            key[j][i] = (256 * j + 4 * lane + i <= t) ? k : 0u; } }
                    else { key[j][0] = 0u; key[j][1] = 0u; key[j][2] = 0u; key[j][3] = 0u; }
                }
                unsigned tau = 1u, I = 0xFFFFFFFFu;
                if (t >= 256) {
                    bool early = false; unsigned prefix = 0u, krem = 256u, msz = (unsigned)t + 1u;
#pragma unroll 1
                    for (int bit = 31; bit >= 0; --bit) {
                        const unsigned cand = prefix | (1u << bit), mh = ~((1u << bit) - 1u); int cnt = 0;
#pragma unroll
                        for (int j = 0; j < 16; ++j) if (j < nj) {
#pragma unroll
                            for (int i = 0; i < 4; ++i) cnt += (int)__popcll(__ballot((key[j][i] & mh) == cand));
                            __builtin_amdgcn_sched_barrier(0); }
                        if ((unsigned)cnt >= krem) { prefix = cand; msz = (unsigned)cnt; } else { krem -= (unsigned)cnt; msz -= (unsigned)cnt; }
                        if (msz == krem) { early = true; break; }
                    }
                    tau = prefix; int ceq = 0;
                    if (!early) {
#pragma unroll
                    for (int j = 0; j < 16; ++j) if (j < nj) {
#pragma unroll
                        for (int i = 0; i < 4; ++i) ceq += (key[j][i] == tau) ? 1 : 0;
                        __builtin_amdgcn_sched_barrier(0); }
                    ceq = wave_isum(ceq); }
                    if ((unsigned)ceq > krem) {
                        unsigned pre = 0u, nd = krem;
#pragma unroll 1
                        for (int bit = 11; bit >= 0; --bit) {
                            const unsigned mh = (~((1u << bit) - 1u)) & 0xFFFu; int cnt = 0;
#pragma unroll
                            for (int j = 0; j < 16; ++j) if (j < nj) {
#pragma unroll
                                for (int i = 0; i < 4; ++i) cnt += (key[j][i] == tau && (((unsigned)(256 * j + 4 * lane + i)) & mh) == pre) ? 1 : 0;
                                __builtin_amdgcn_sched_barrier(0); }
                            cnt = wave_isum(cnt);
                            if ((unsigned)cnt < nd) { nd -= (unsigned)cnt; pre |= 1u << bit; }
                        }
                        I = pre;
                    }
                }
                unsigned long long myw = 0ull;
#pragma unroll
                for (int j = 0; j < 16; ++j) if (j < nj) {
#pragma unroll
                    for (int i = 0; i < 4; ++i) { const unsigned idx = (unsigned)(256 * j + 4 * lane + i);
                        const unsigned long long w = __ballot(key[j][i] > tau || (key[j][i] == tau && idx <= I)); if (lane == 4 * j + i) myw = w; }
                    __builtin_amdgcn_sched_barrier(0); }
                return myw;
}
#ifdef ORACLE
__device__ __forceinline__ float wave_max(float v) {
#pragma unroll
    for (int o = 1; o < 64; o <<= 1) v = fmaxf(v, __shfl_xor(v, o));
    return v;
}
__device__ __forceinline__ void oracle_row(const int MODE, const int DV, const bf16* Qrow, const bf16* Kp, int ldk, const bf16* Vp, int ldv, const float* kb, const unsigned long long* bmrow,
                                           int t, float m_init, float l_init, float& o0, float& o1) {
    const int lane = threadIdx.x & 63;
    const float q = bf2f(Qrow[lane]);
    float m = m_init, l = l_init, a0 = 0.f, a1 = 0.f;
#pragma unroll 1
    for (int k = 0; k <= t; ++k) {
        if (MODE == 2 && t - k >= 128) continue;
        if (MODE == 3) { const int j = k >> 8, i = k & 3, lb = (k & 255) >> 2; if (!((bmrow[4 * j + i] >> lb) & 1ull)) continue; }
        float s = wave_sum(q * bf2f(Kp[(size_t)k * ldk + lane]));
        if (MODE == 0) s += kb[k];
        const float mn = fmaxf(m, s), al = exp2f(m - mn), e = exp2f(s - mn);
        l = l * al + e; a0 = a0 * al + e * bf2f(Vp[(size_t)k * ldv + lane]);
        if (DV == 128) a1 = a1 * al + e * bf2f(Vp[(size_t)k * ldv + 64 + lane]);
        m = mn;
    }
    o0 = a0 / l; o1 = a1 / l;
}
__device__ __forceinline__ void oracle_flag(unsigned char* ws, float err2, float ref2, int bit) {
    if ((threadIdx.x & 63) == 0 && !(err2 <= 0.0025f * ref2)) atomicOr((unsigned*)(ws + 900 * 1024), 1u << bit);
}
#endif
#ifdef ORACLE
__device__ __forceinline__ void oracle_check(unsigned char* ws_in, int L) {
    unsigned char* ws = opq(ws_in);
    int tid_ = threadIdx.x; asm volatile("" : "+v"(tid_));
    const int lane = tid_ & 63, gw = blockIdx.x * NWAVES + __builtin_amdgcn_readfirstlane(tid_ >> 6);
    const float* par = (const float*)ws; const bf16* ATT = (const bf16*)(ws + WS_ATT); const bf16* P = (const bf16*)(ws + WS_BIG);
    if (gw < 32) {
        const int ob = gw & 7, oh = (gw * 5) & 15, ti = (gw >> 2) & 7;
        const int ot = ti == 0 ? 3 : ti == 1 ? 77 : ti == 2 ? 255 : ti == 3 ? 256 : ti == 4 ? 700 : ti == 5 ? 1500 : ti == 6 ? 3000 : 4095;
        const size_t orow = (size_t)ob * SEQ + ot; float x0, x1;
        if (L == 0) {
            const bf16* KD = (const bf16*)(ws + WS_KD); const bf16* VD = (const bf16*)(ws + WS_VD); const unsigned long long* BM = (const unsigned long long*)(ws + WS_BM); const float* SC = (const float*)(ws + WS_SC);
            oracle_row(3, 64, P + orow * 1536 + oh * 64, KD + (size_t)ob * SEQ * 64, 64, VD + (size_t)ob * SEQ * 64, 64, nullptr, BM + orow * 64, ot, NEGBIG, 0.f, x0, x1);
            const float y = bf2f(ATT[orow * DM + oh * 64 + lane]);
            oracle_flag(ws, wave_sum((x0 - y) * (x0 - y)), wave_sum(x0 * x0), 0);
            const float* srow = SC + sc_rowoff(ob, ot); float mins = 3e38f, maxu = -3e38f; int cnt = 0;
            for (int k = lane; k <= ot; k += 64) { const int j = k >> 8, i = k & 3, lb = (k & 255) >> 2; const bool sel = (BM[orow * 64 + 4 * j + i] >> lb) & 1ull; const float s = srow[k];
                if (sel) { mins = fminf(mins, s); ++cnt; } else maxu = fmaxf(maxu, s); }
            cnt = wave_isum(cnt); mins = -wave_max(-mins); maxu = wave_max(maxu);
            const int want = ot + 1 < 256 ? ot + 1 : 256;
            oracle_flag(ws, (cnt == want && mins >= maxu) ? 0.f : 1.f, 1.f, 4);
        } else if (L == 1) {
            const float* CT = (const float*)(ws + WS_CUMT); const bf16* Pb = P + (size_t)ob * SEQ * 3328;
            oracle_row(0, 64, P + orow * 3328 + oh * 64, Pb + 1024 + oh * 64, 3328, Pb + 2048 + oh * 64, 3328, CT + (size_t)(ob * 16 + oh) * SEQ, nullptr, ot, NEGBIG, 0.f, x0, x1);
            const float y = bf2f(ATT[orow * DM + oh * 64 + lane]);
            oracle_flag(ws, wave_sum((x0 - y) * (x0 - y)), wave_sum(x0 * x0), 1);
        } else if (L == 2) {
            const bf16* Pb = P + (size_t)ob * SEQ * 1280; const int gk = oh >> 3;
            oracle_row(2, 64, P + orow * 1280 + oh * 64, Pb + 1024 + gk * 64, 1280, Pb + 1152 + gk * 64, 1280, nullptr, nullptr, ot, par[PAR_SINK + oh] * LOG2E, 1.0f, x0, x1);
            const float y = bf2f(ATT[orow * DM + oh * 64 + lane]);
            oracle_flag(ws, wave_sum((x0 - y) * (x0 - y)), wave_sum(x0 * x0), 2);
        } else {
            const bf16* Pb = P + (size_t)ob * SEQ * 3072; const int hh = oh & 7; float z0, z1;
            const float lambda_init = 0.8f - 0.6f * 0.40656965974059911f;
            const float s01 = wave_sum(par[PAR_LAM + lane] * par[PAR_LAM + 64 + lane]), s23 = wave_sum(par[PAR_LAM + 128 + lane] * par[PAR_LAM + 192 + lane]);
            const float lam = expf(s01) - expf(s23) + lambda_init;
            oracle_row(1, 128, P + orow * 3072 + (2 * hh) * 64, Pb + 1024 + (2 * hh) * 64, 3072, Pb + 2048 + hh * 128, 3072, nullptr, nullptr, ot, NEGBIG, 0.f, x0, x1);
            oracle_row(1, 128, P + orow * 3072 + (2 * hh + 1) * 64, Pb + 1024 + (2 * hh + 1) * 64, 3072, Pb + 2048 + hh * 128, 3072, nullptr, nullptr, ot, NEGBIG, 0.f, z0, z1);
            float v0 = x0 - lam * z0, v1 = x1 - lam * z1; const float ss = wave_sum(v0 * v0 + v1 * v1);
            const float rs = (1.0f / sqrtf(ss * (1.0f / 128.0f) + 1e-6f)) * (1.0f - lambda_init);
            v0 *= rs * par[PAR_SUBLN + lane]; v1 *= rs * par[PAR_SUBLN + 64 + lane];
            const float y0 = bf2f(ATT[orow * DM + hh * 128 + lane]), y1 = bf2f(ATT[orow * DM + hh * 128 + 64 + lane]);
            oracle_flag(ws, wave_sum((v0 - y0) * (v0 - y0) + (v1 - y1) * (v1 - y1)), wave_sum(v0 * v0 + v1 * v1), 3);
        }
    }
}
__global__ void __launch_bounds__(NTHREADS) oracle_kernel(unsigned char* ws, int L) { oracle_check(ws, L); }
#endif

__device__ __forceinline__ void mixer_layer(unsigned char* ws_in, float* out, int L, LAS unsigned char* lds, const XcdBarrier& bar) {
    unsigned char* const ws = ws_in;
#define MIX_VARS() unsigned char* w_ = opq(ws); int tid_ = threadIdx.x; asm volatile("" : "+v"(tid_)); \
    const int tid = tid_, lane = tid & 63, wid = __builtin_amdgcn_readfirstlane(tid >> 6), r32 = lane & 31, hi = lane >> 5; \
    const int G = gridDim.x, gw = blockIdx.x * NWAVES + wid, ngw = G * NWAVES; \
    const int vcu = (G % 8 == 0) ? (int)(blockIdx.x % 8) * (G / 8) + (int)(blockIdx.x / 8) : (int)blockIdx.x;     \
    const float* par = (const float*)w_; bf16* const ATT = (bf16*)(w_ + WS_ATT); bf16* const P = (bf16*)(w_ + WS_BIG); \
    (void)vcu; (void)tid; (void)lane; (void)r32; (void)hi; (void)G; (void)gw; (void)ngw; (void)par; (void)ATT; (void)P
    {
        unsigned char* w_ = opq(ws); const int G = gridDim.x;
        const int Npad = L == 0 ? 1536 : L == 1 ? 3328 : L == 2 ? 1280 : 3072;
        const size_t woff = L == 0 ? W_DSA : L == 1 ? W_FOX : L == 2 ? W_SWA : W_DIFF;
        const float* cos16 = (const float*)(w_ + WS_ROPE); const float* sin16 = cos16 + SEQ * 8; const float* cos8 = sin16 + SEQ * 8; const float* sin8 = cos8 + SEQ * 4;
        pg8::Gemm g{(const bf16*)(w_ + WS_H), (const bf16*)(w_ + WS_W + woff), M, Npad, DM}; pg8::StaticOrder S; S.init(M, Npad, G, (int)blockIdx.x);
        EpiProj E; E.O = (bf16*)(w_ + WS_BIG); E.ldc = Npad; E.q_end = 1024; E.rope_end = L == 0 ? 1024 : L == 1 ? 0 : L == 2 ? 1152 : 2048;
        E.idx_lo = L == 0 ? 1152 : (1 << 30); E.idx_hi = L == 0 ? 1440 : (1 << 30); E.w_lo = L == 0 ? 1440 : -1; E.f_lo = L == 1 ? 3072 : -1;
        E.flog = (float*)(w_ + WS_FLOG); E.cos16 = cos16; E.sin16 = sin16; E.cos8 = cos8; E.sin8 = sin8;
        _Pragma("unroll 1") for (int rep_ = 0, nrep_ = opq_i(1 + RPT_INPROJ); rep_ < nrep_; ++rep_) pg8::gemm_phase<EpiProj, pg8::StaticOrder, true, true>(lds, g, S, E);
    }
    xsync(bar);
    if (L == 0) {
        {
            MIX_VARS(); bf16* const KD = (bf16*)(w_ + WS_KD); bf16* const VD = (bf16*)(w_ + WS_VD);
            const float* cos16 = (const float*)(w_ + WS_ROPE); const float* sin16 = cos16 + SEQ * 8;
            LAS float* Wl = (LAS float*)lds; LAS float* cn = (LAS float*)(lds + 65536 + wid * 2048);
            for (int i = tid; i < 16384; i += NTHREADS) Wl[i] = par[PAR_KVUP + i];
            __syncthreads();
            _Pragma("unroll 1") for (int rep_ = 0, nrep_ = opq_i(1 + RPT_DSAX); rep_ < nrep_; ++rep_)
            for (int t4 = gw; t4 < M / 4; t4 += ngw) {
#pragma unroll
                for (int tk = 0; tk < 4; ++tk) { const size_t row = (size_t)4 * t4 + tk; const float c0 = bf2f(P[row * 1536 + 1024 + lane]), c1 = bf2f(P[row * 1536 + 1088 + lane]);
                    const float ss = wave_sum(c0 * c0 + c1 * c1); const float r = 1.0f / sqrtf(ss * (1.0f / 128.0f) + 1e-6f);
                    cn[tk * 128 + lane] = c0 * r * par[PAR_KVN + lane]; cn[tk * 128 + 64 + lane] = c1 * r * par[PAR_KVN + 64 + lane]; }
                LDS_WAIT(); asm volatile("" ::: "memory");
                float acc[4][2];
#pragma unroll
                for (int tk = 0; tk < 4; ++tk) { acc[tk][0] = 0.f; acc[tk][1] = 0.f; }
#pragma unroll 4
                for (int k = 0; k < 128; ++k) { const float w0 = Wl[k * 128 + lane], w1 = Wl[k * 128 + 64 + lane];
#pragma unroll
                    for (int tk = 0; tk < 4; ++tk) { const float av = cn[tk * 128 + k]; acc[tk][0] += av * w0; acc[tk][1] += av * w1; } }
#pragma unroll
                for (int tk = 0; tk < 4; ++tk) { const size_t row = (size_t)4 * t4 + tk; const int pos = (int)(row & (SEQ - 1));
                    const float oth = __shfl_xor(acc[tk][0], 8); float kk = acc[tk][0];
                    if (lane < 16) { const float cs = cos16[pos * 8 + (lane & 7)], sn = sin16[pos * 8 + (lane & 7)]; kk = lane < 8 ? kk * cs - oth * sn : kk * cs + oth * sn; }
                    KD[row * 64 + lane] = (bf16)f2bf(kk); VD[row * 64 + lane] = (bf16)f2bf(acc[tk][1]); }
                LDS_WAIT(); asm volatile("" ::: "memory");
            }
        }
        {
            MIX_VARS(); float* const SC = (float*)(w_ + WS_SC);
            _Pragma("unroll 1") for (int rep_ = 0, nrep_ = opq_i(1 + RPT_DSAX); rep_ < nrep_; ++rep_)
            for (int u = blockIdx.x; u < 1024; u += G) {
                const int c = u & 255, j = u >> 8, b = c >> 5, s = c & 31, qb = j == 0 ? s : j == 1 ? 63 - s : j == 2 ? 64 + s : 127 - s;
                const size_t row = (size_t)b * SEQ + 32 * qb + r32;
                bf16x8 qf[8][2]; float wq[8];
#pragma unroll
                for (int h = 0; h < 8; ++h) { qf[h][0] = *(const bf16x8*)(P + row * 1536 + 1152 + h * 32 + 8 * hi); qf[h][1] = *(const bf16x8*)(P + row * 1536 + 1152 + h * 32 + 16 + 8 * hi); wq[h] = bf2f(P[row * 1536 + 1440 + h]); }
                float* const srow = SC + sc_rowoff(b, 32 * qb + r32);
                bf16x8 kn0 = qf[0][0], kn1 = qf[0][0];
                if (wid <= qb) { const size_t kr = (size_t)b * SEQ + 32 * wid + r32; kn0 = *(const bf16x8*)(P + kr * 1536 + 1408 + 8 * hi); kn1 = *(const bf16x8*)(P + kr * 1536 + 1408 + 16 + 8 * hi); }
                for (int jt = wid; jt <= qb; jt += NWAVES) {
                    const bf16x8 kf0 = kn0, kf1 = kn1;
                    if (jt + NWAVES <= qb) { const size_t kr = (size_t)b * SEQ + 32 * (jt + NWAVES) + r32; kn0 = *(const bf16x8*)(P + kr * 1536 + 1408 + 8 * hi); kn1 = *(const bf16x8*)(P + kr * 1536 + 1408 + 16 + 8 * hi); }
                    f32x16 sc;
#pragma unroll
                    for (int r = 0; r < 16; ++r) sc[r] = 0.f;
#pragma unroll
                    for (int h = 0; h < 8; ++h) { f32x16 z;
#pragma unroll
                        for (int r = 0; r < 16; ++r) z[r] = 0.f;
                        z = mfma32(kf0, qf[h][0], z); z = mfma32(kf1, qf[h][1], z);
#pragma unroll
                        for (int r = 0; r < 16; ++r) sc[r] += wq[h] * fmaxf(z[r], 0.f);
                        __builtin_amdgcn_sched_barrier(0); }
#pragma unroll
                    for (int g = 0; g < 4; ++g) { f32x4 v; v[0] = sc[4 * g] + 0.0f; v[1] = sc[4 * g + 1] + 0.0f; v[2] = sc[4 * g + 2] + 0.0f; v[3] = sc[4 * g + 3] + 0.0f;
                        *(f32x4*)(srow + 32 * jt + 8 * g + 4 * hi) = v; }
                }
            }
        }
        xsync(bar);
        {
            MIX_VARS(); const float* const SC = (const float*)(w_ + WS_SC); unsigned long long* const BM = (unsigned long long*)(w_ + WS_BM);
            _Pragma("unroll 1") for (int rep_ = 0, nrep_ = opq_i(1 + RPT_DSAX); rep_ < nrep_; ++rep_) {
            f32x4 raw[16];
#define SEL_BT(R_, b_, t_) const int b_ = (R_) >> 12, tt_##t_ = (R_) & 4095, t_ = tt_##t_ < 2048 ? tt_##t_ : 6143 - tt_##t_
            if (gw < M) { SEL_BT(gw, b0, t0); select_load(SC + sc_rowoff(b0, t0), (t0 >> 8) + 1, lane, raw); }
            for (int R = gw; R < M; R += ngw) {
                SEL_BT(R, b, t); const int nj = (t >> 8) + 1;
                f32x4 cur[16];
#pragma unroll
                for (int j = 0; j < 16; ++j) cur[j] = raw[j];
                if (R + ngw < M) { SEL_BT(R + ngw, bn, tn); select_load(SC + sc_rowoff(bn, tn), (tn >> 8) + 1, lane, raw); }
                const unsigned long long myw = select_row(cur, t, nj, lane);
                if (lane < 4 * nj) BM[((size_t)b * SEQ + t) * 64 + lane] = myw;
            }
#undef SEL_BT
            }
        }
        xsync(bar);
        {
            MIX_VARS(); const bf16* const KD = (const bf16*)(w_ + WS_KD); const bf16* const VD = (const bf16*)(w_ + WS_VD); const unsigned long long* const BM = (const unsigned long long*)(w_ + WS_BM);
            _Pragma("unroll 1") for (int rep_ = 0, nrep_ = opq_i(1 + RPT_ATT); rep_ < nrep_; ++rep_)
            for (int u = vcu; u < 1024; u += G) {
                const int c = u & 255, j = u >> 8, bhp = c >> 2, qd = c & 3, pi = (j >> 1) ? 7 - qd : qd, qb = (j & 1) ? 15 - pi : pi, b = bhp >> 3, h = 2 * (bhp & 7), q0 = qb * 256;
                const size_t row = (size_t)b * SEQ + q0 + 32 * wid + r32;
                f32x16 o[2], o2[2]; float l, l2;
                attn_core_h2<64, 3>(lds, P + row * 1536 + h * 64, P + row * 1536 + (h + 1) * 64, KD + (size_t)b * SEQ * 64, 64, VD + (size_t)b * SEQ * 64, 64, nullptr, BM + row * 64, q0, 0, (q0 + 256) / 64, NEGBIG, 0.f, o, l, o2, l2);
                store_o<64>(o, 1.0f / l, ATT + row * DM + h * 64, hi);
                store_o<64>(o2, 1.0f / l2, ATT + row * DM + (h + 1) * 64, hi);
            }
        }
    } else if (L == 1) {
        { MIX_VARS(); float* const FL = (float*)(w_ + WS_FLOG); float* const CT = (float*)(w_ + WS_CUMT);
        for (int task = gw; task < 128; task += ngw) {
            const int b = task >> 4, h = task & 15; const float* fp = FL + ((size_t)b * SEQ + 64 * lane) * 16 + h;
            const float fb = par[PAR_FB + h]; float s = 0.f;
#pragma unroll 8
            for (int i = 0; i < 64; ++i) { const float x = fp[(size_t)i * 16] + fb; s += fminf(x, 0.f) - log1pf(expf(-fabsf(x))); }
            float inc = s;
#pragma unroll
            for (int o_ = 1; o_ < 64; o_ <<= 1) { const float n = __shfl_up(inc, o_); if (lane >= o_) inc += n; }
            float run = inc - s; float* cp = CT + (size_t)task * SEQ + 64 * lane;
#pragma unroll 8
            for (int i = 0; i < 64; ++i) { const float x = fp[(size_t)i * 16] + fb; run += fminf(x, 0.f) - log1pf(expf(-fabsf(x))); cp[i] = -run * LOG2E; }
        } }
        xsync(bar);
        { MIX_VARS(); const float* const CT = (const float*)(w_ + WS_CUMT);
        _Pragma("unroll 1") for (int rep_ = 0, nrep_ = opq_i(1 + RPT_ATT); rep_ < nrep_; ++rep_)
        for (int u = vcu; u < 2048; u += G) {
            const int c = u & 255, j = u >> 8, bh = c >> 1, s = 4 * (c & 1) + (j >> 1), qb = (j & 1) ? 15 - s : s, b = bh >> 4, h = bh & 15, q0 = qb * 256;
            const size_t row = (size_t)b * SEQ + q0 + 32 * wid + r32; const bf16* Pb = P + (size_t)b * SEQ * 3328;
            f32x16 o[2]; float l;
            attn_core<64, 0>(lds, P + row * 3328 + h * 64, Pb + 1024 + h * 64, 3328, Pb + 2048 + h * 64, 3328, CT + (size_t)bh * SEQ, nullptr, q0, 0, (q0 + 256) / 64, NEGBIG, 0.f, o, l);
            store_o<64>(o, 1.0f / l, ATT + row * DM + h * 64, hi);
        } }
    } else if (L == 2) {
        MIX_VARS();
        _Pragma("unroll 1") for (int rep_ = 0, nrep_ = opq_i(1 + RPT_ATT); rep_ < nrep_; ++rep_)
        for (int u = blockIdx.x; u < 2048; u += G) {
            const int b = u >> 8, h = (u >> 4) & 15, qb = u & 15, q0 = qb * 256, gk = h >> 3;
            const size_t row = (size_t)b * SEQ + q0 + 32 * wid + r32; const bf16* Pb = P + (size_t)b * SEQ * 1280;
            f32x16 o[2]; float l;
            attn_core<64, 2>(lds, P + row * 1280 + h * 64, Pb + 1024 + gk * 64, 1280, Pb + 1152 + gk * 64, 1280, nullptr, nullptr, q0, (4 * qb - 2 > 0 ? 4 * qb - 2 : 0), 4 * qb + 4,
                             par[PAR_SINK + h] * LOG2E, 1.0f, o, l);
            store_o<64>(o, 1.0f / l, ATT + row * DM + h * 64, hi);
        }
    } else {
        MIX_VARS();
        const float lambda_init = 0.8f - 0.6f * 0.40656965974059911f;
        const float s01 = wave_sum(par[PAR_LAM + lane] * par[PAR_LAM + 64 + lane]), s23 = wave_sum(par[PAR_LAM + 128 + lane] * par[PAR_LAM + 192 + lane]);
        const float lam = expf(s01) - expf(s23) + lambda_init;
        _Pragma("unroll 1") for (int rep_ = 0, nrep_ = opq_i(1 + RPT_ATT); rep_ < nrep_; ++rep_)
        for (int u = vcu; u < 1024; u += G) {
            const int c = u & 255, j = u >> 8, bhh = c >> 2, qd = c & 3, pi = (j >> 1) ? 7 - qd : qd, qb = (j & 1) ? 15 - pi : pi, b = bhh >> 3, hh = bhh & 7, q0 = qb * 256;
            const size_t row = (size_t)b * SEQ + q0 + 32 * wid + r32; const bf16* Pb = P + (size_t)b * SEQ * 3072;
            f32x16 o1[4]; float l0, l1;
            float* park = (float*)(w_ + WS_PARK) + ((size_t)(blockIdx.x * NWAVES + wid) * 64 + lane) * 64;
            {
                f32x16 o0[4];
                attn_core<128, 1>(lds, P + row * 3072 + (2 * hh) * 64, Pb + 1024 + (2 * hh) * 64, 3072, Pb + 2048 + hh * 128, 3072, nullptr, nullptr, q0, 0, (q0 + 256) / 64, NEGBIG, 0.f, o0, l0);
                const float i0 = 1.0f / l0;
#pragma unroll
                for (int dh = 0; dh < 4; ++dh)
#pragma unroll
                    for (int g = 0; g < 4; ++g) { f32x4 v; v[0] = o0[dh][4 * g] * i0; v[1] = o0[dh][4 * g + 1] * i0; v[2] = o0[dh][4 * g + 2] * i0; v[3] = o0[dh][4 * g + 3] * i0; *(f32x4*)(park + dh * 16 + 4 * g) = v; }
            }
            attn_core<128, 1>(lds, P + row * 3072 + (2 * hh + 1) * 64, Pb + 1024 + (2 * hh + 1) * 64, 3072, Pb + 2048 + hh * 128, 3072, nullptr, nullptr, q0, 0, (q0 + 256) / 64, NEGBIG, 0.f, o1, l1);
            const float i1 = lam / l1; float ss = 0.f;
#pragma unroll
            for (int dh = 0; dh < 4; ++dh)
#pragma unroll
                for (int g = 0; g < 4; ++g) { const f32x4 pv = *(const f32x4*)(park + dh * 16 + 4 * g);
#pragma unroll
                    for (int i = 0; i < 4; ++i) { const float v = pv[i] - o1[dh][4 * g + i] * i1; o1[dh][4 * g + i] = v; ss += v * v; } }
            ss += __shfl_xor(ss, 32);
            const float rs = (1.0f / sqrtf(ss * (1.0f / 128.0f) + 1e-6f)) * (1.0f - lambda_init);
            bf16* orow = ATT + row * DM + hh * 128;
#pragma unroll
            for (int dh = 0; dh < 4; ++dh)
#pragma unroll
                for (int g = 0; g < 4; ++g) { const int d = 32 * dh + 8 * g + 4 * hi; const f32x4 sg = *(const f32x4*)(par + PAR_SUBLN + d);
                    u32x2 w; w.x = pk2(o1[dh][4 * g] * rs * sg[0], o1[dh][4 * g + 1] * rs * sg[1]); w.y = pk2(o1[dh][4 * g + 2] * rs * sg[2], o1[dh][4 * g + 3] * rs * sg[3]);
                    *(u32x2*)(orow + d) = w; }
        }
    }
    xsync(bar);
    {
        unsigned char* w_ = opq(ws);
        pg8::Gemm g{(const bf16*)(w_ + WS_ATT), (const bf16*)(w_ + WS_W + W_OUT + (size_t)L * 1024 * 2048), M, DM, DM}; pg8::StaticOrder S; S.init(M, DM, (int)gridDim.x, (int)blockIdx.x);
        EpiResid<0> E{w_, (const f16*)out, (f16*)out, (L * 72 + 5) | ((L * 3) << 10) | ((12 + L * 3) << 20)}; pg8::gemm_phase<EpiResid<0>, pg8::StaticOrder, EPIRES_ALIGN, true>(lds, g, S, E);
    }
    xsync(bar);
}
struct Args { const float* in[22]; float* out; unsigned char* ws; int s0, s1; };

__device__ __forceinline__ void sincos_d(double a, float& sn, float& cs) {
    const double n = __builtin_rint(a * 0.63661977236758134308);
    const double r = __builtin_fma(-n, 1.57079632679489661923, a) - n * 6.123233995736766e-17;
    const double r2 = r * r;
    double s = -1.0 / 1307674368000.0; s = s * r2 + 1.0 / 6227020800.0; s = s * r2 - 1.0 / 39916800.0; s = s * r2 + 1.0 / 362880.0; s = s * r2 - 1.0 / 5040.0; s = s * r2 + 1.0 / 120.0; s = s * r2 - 1.0 / 6.0; s = s * r2 * r + r;
    double c = 1.0 / 87178291200.0; c = c * r2 - 1.0 / 479001600.0; c = c * r2 + 1.0 / 3628800.0; c = c * r2 - 1.0 / 40320.0; c = c * r2 + 1.0 / 720.0; c = c * r2 - 1.0 / 24.0; c = c * r2 + 0.5; c = 1.0 - c * r2;
    const int q = ((int)n) & 3;
    const double ss = (q == 0) ? s : (q == 1) ? c : (q == 2) ? -s : -c;
    const double cc = (q == 0) ? c : (q == 1) ? -s : (q == 2) ? -c : s;
    sn = (float)ss; cs = (float)cc;
}

#ifndef MIXERS
#define MIXERS 1
#endif
#ifndef STUBMASK
#define STUBMASK 0
#endif

__global__ void __launch_bounds__(NTHREADS, 2) mega(Args a) {
    extern __shared__ __attribute__((aligned(16))) unsigned char lds_raw[];
    LAS unsigned char* lds = (LAS unsigned char*)lds_raw;
    cg::grid_group grid = cg::this_grid();
    const int tid = threadIdx.x, lane = tid & 63, wid = __builtin_amdgcn_readfirstlane(tid >> 6);
    const int G = gridDim.x, gw = blockIdx.x * NWAVES + wid, ngw = G * NWAVES;
    unsigned char* const ws = a.ws;
    if (tid < 2) ((volatile LAS unsigned*)(lds + LDS_MISC))[tid] = 0u;
    __syncthreads();
    const XcdBarrier bar = xcd_barrier_post((unsigned*)(ws + WS_CTLZ), (volatile LAS unsigned*)(lds + LDS_MISC));
    float* const cos16 = (float*)(ws + WS_ROPE); float* const sin16 = cos16 + SEQ * 8; float* const cos8 = sin16 + SEQ * 8; float* const sin8 = cos8 + SEQ * 4;

    if (a.s0 == 0) {
    {
#ifdef ORACLE
        if (blockIdx.x == 0 && tid == 0) *(unsigned*)(ws + 900 * 1024) = 0u;
#endif
        LAS float* scr = (LAS float*)(lds + wid * 16384);
#define CONV_DECODE(it_, d_) do { int r = (it_); \
            if (r < 22528) { const int mi = r / 2816; d_ = ConvDesc{a.in[6] + (size_t)mi * 1024 * 5632, (bf16*)(ws + WS_W + W_FI + mi * W_FI_SZ), 1024, 5632, 5632, r % 2816, true}; break; } r -= 22528; \
            if (r < 11264) { const int mi = r / 1408; d_ = ConvDesc{a.in[7] + (size_t)mi * 2816 * 1024, (bf16*)(ws + WS_W + W_FO + mi * W_FO_SZ), 2816, 1024, 1024, r % 1408, false}; break; } r -= 11264; \
            if (r < 768) { d_ = ConvDesc{a.in[8], (bf16*)(ws + WS_W + W_DSA), 1024, 1448, 1536, r, false}; break; } r -= 768; \
            if (r < 1664) { d_ = ConvDesc{a.in[12], (bf16*)(ws + WS_W + W_FOX), 1024, 3088, 3328, r, false}; break; } r -= 1664; \
            if (r < 640) { d_ = ConvDesc{a.in[15], (bf16*)(ws + WS_W + W_SWA), 1024, 1280, 1280, r, false}; break; } r -= 640; \
            if (r < 1536) { d_ = ConvDesc{a.in[18], (bf16*)(ws + WS_W + W_DIFF), 1024, 3072, 3072, r, false}; break; } r -= 1536; \
            { const int mi = r / 512; const float* src = mi == 0 ? a.in[11] : mi == 1 ? a.in[14] : mi == 2 ? a.in[17] : a.in[21]; \
              d_ = ConvDesc{src, (bf16*)(ws + WS_W + W_OUT + (size_t)mi * 1024 * 2048), 1024, 1024, 1024, r % 512, false}; } } while (0)
        _Pragma("unroll 1") for (int rep_ = 0, nrep_ = opq_i(1 + RPT_P0); rep_ < nrep_; ++rep_) {
            ConvDesc dc{}, dn{}; f32x4 lc[8], ln[8];
            if (gw < 40448) { CONV_DECODE(gw, dn); conv_load(dn, lane, ln); }
            for (int it = gw; it < 40448; it += ngw) {
                dc = dn;
#pragma unroll
                for (int i = 0; i < 8; ++i) lc[i] = ln[i];
                if (it + ngw < 40448) { CONV_DECODE(it + ngw, dn); conv_load(dn, lane, ln); }
                conv_store(dc, scr, lane, lc);
            }
        }
#undef CONV_DECODE
        for (int idx = blockIdx.x * NTHREADS + tid; idx < SEQ * 12; idx += G * NTHREADS) {
            const float inv16[8] = {1.0f, 0.1939227432012558f, 0.03760603070259094f, 0.007292664609849453f, 0.0014142135623842478f, 0.00027424818836152554f, 5.318296098266728e-05f, 1.0313386155758053e-05f};
            float sn, cs;
            if (idx < SEQ * 8) { const int pos = idx >> 3, i = idx & 7; const float inv = i == 0 ? inv16[0] : i == 1 ? inv16[1] : i == 2 ? inv16[2] : i == 3 ? inv16[3] : i == 4 ? inv16[4] : i == 5 ? inv16[5] : i == 6 ? inv16[6] : inv16[7];
                const float ang = (float)pos * inv; sincos_d((double)ang, sn, cs); cos16[idx] = cs; sin16[idx] = sn; }
            else { const int j = idx - SEQ * 8, pos = j >> 2, i = j & 3; const float inv = i == 0 ? inv16[0] : i == 1 ? inv16[2] : i == 2 ? inv16[4] : inv16[6];
                const float ang = (float)pos * inv; sincos_d((double)ang, sn, cs); cos8[j] = cs; sin8[j] = sn; }
        }
        {
            float* par = (float*)ws;
            for (int i = blockIdx.x * NTHREADS + tid; i < PAR_N; i += G * NTHREADS) {
                float v;
                if (i < 12288) v = a.in[2][i]; else if (i < 24576) v = a.in[3][i - 12288]; else if (i < 24704) v = a.in[9][i - 24576]; else if (i < 41088) v = a.in[10][i - 24704];
                else if (i < 41104) v = a.in[13][i - 41088]; else if (i < 41120) v = a.in[16][i - 41104]; else if (i < 41376) v = a.in[19][i - 41120]; else if (i < 41504) v = a.in[20][i - 41376]; else v = (i >= PAR_ONE && i < PAR_ZERO) ? 1.0f : 0.0f;
                par[i] = v; }
        }
        __syncthreads();
        LAS float* cond = (LAS float*)lds;
        for (int i = tid; i < NBATCH * DM; i += NTHREADS) { const float c = a.in[1][i]; cond[i] = c / (1.0f + expf(-c)); }
        __syncthreads();
        float* modp = (float*)(ws + WS_BIG);
        for (int task = gw; task < 2304; task += ngw) {
            const int kc = task / 288, cgp = task % 288, layer = cgp / 72, col = (cgp % 72) * 128 + (lane & 31) * 4, kpar = lane >> 5;
            f32x4 acc[8];
#pragma unroll
            for (int b = 0; b < 8; ++b) acc[b] = (f32x4){0.f, 0.f, 0.f, 0.f};
            const float* wp = a.in[4] + ((size_t)layer * 1024 + kc * 128 + kpar) * MODW + col;
#pragma unroll 4
            for (int kk = 0; kk < 64; ++kk) { const f32x4 w4 = *(const f32x4*)(wp + (size_t)(2 * kk) * MODW); const int k = kc * 128 + 2 * kk + kpar;
#pragma unroll
                for (int b = 0; b < 8; ++b) acc[b] += w4 * cond[b * 1024 + k]; }
#pragma unroll
            for (int b = 0; b < 8; ++b)
#pragma unroll
                for (int i = 0; i < 4; ++i) acc[b][i] += __shfl_xor(acc[b][i], 32);
            if (kpar == 0) {
#pragma unroll
                for (int b = 0; b < 8; ++b) *(f32x4*)(modp + (size_t)kc * 294912 + ((size_t)layer * 8 + b) * MODW + col) = acc[b]; }
        }
    }
    gsync(grid);
    {
        const float* modp = (const float*)(ws + WS_BIG);
        for (int i = blockIdx.x * NTHREADS + tid; i < 294912; i += G * NTHREADS) {
            const int layer = i / 73728, col = i % MODW; float s = a.in[5][layer * MODW + col];
#pragma unroll
            for (int kc = 0; kc < 8; ++kc) s += modp[(size_t)kc * 294912 + i];
            ((float*)(ws + WS_MOD))[i] = s; }
    }
    xsync(bar);
    { unsigned char* w = opq(ws); const float* md = (const float*)(w + WS_MOD); ln_rows<false>(a.in[0], (f16*)a.out, nullptr, (bf16*)(w + WS_H), nullptr, nullptr, md + 1024, md, false, true, 1.0f, (float*)(w + WS_STATS), false); }
    xsync(bar);
    }

#pragma unroll 1
    for (int L = 0; L < NLAYER; ++L) {
#pragma unroll 1
        for (int sub = 0; sub < 3; ++sub) {
            if (L * 3 + sub < a.s0 || L * 3 + sub >= a.s1) continue;
            float pre = 1.0f;
            if (sub != 1) {
                const int fi = L * 2 + (sub >> 1);
                { unsigned char* w = opq(ws);
                  pg8::Gemm g{(const bf16*)(w + WS_H), (const bf16*)(w + WS_W + W_FI + fi * W_FI_SZ), M, 2 * FF, DM}; pg8::StaticOrder S; S.init(M, 2 * FF, (int)gridDim.x, (int)blockIdx.x);
                  EpiSwiGLU E{(bf16*)(w + WS_BIG), FF}; _Pragma("unroll 1") for (int rep_ = 0, nrep_ = opq_i(1 + RPT_FFNUP); rep_ < nrep_; ++rep_) pg8::gemm_phase<EpiSwiGLU, pg8::StaticOrder, FFNUP_ALIGN, true>(lds, g, S, E); }
                xsync(bar);
                { unsigned char* w = opq(ws); const f16* xres = (const f16*)a.out; f16* vout = (L == NLAYER - 1 && sub == 2) ? (f16*)(w + WS_PARK) : (f16*)a.out;
                  pg8::Gemm g{(const bf16*)(w + WS_BIG), (const bf16*)(w + WS_W + W_FO + fi * W_FO_SZ), M, DM, FF}; pg8::StaticOrder S; S.init(M, DM, (int)gridDim.x, (int)blockIdx.x);
                  const bool first = (L == 0 && sub == 0); const int pidx = L * 3 + sub - 1;
                  const int code = (L * 72 + 3 * sub + 2) | ((first ? PAR_ONE / 1024 : pidx) << 10) | ((first ? PAR_ZERO / 1024 : 12 + pidx) << 20);
#if RPT_FFNDN
                  { EpiResid<1> Ed{w, xres, (f16*)(w + WS_PARK + 64 * MiB), code}; pg8::gemm_phase<EpiResid<1>, pg8::StaticOrder, EPIRES_ALIGN, true>(lds, g, S, Ed); xsync(bar); }
#endif
                  EpiResid<1> E{w, xres, vout, code}; pg8::gemm_phase<EpiResid<1>, pg8::StaticOrder, EPIRES_ALIGN, true>(lds, g, S, E); }
                xsync(bar);
            } else {
#if MIXERS
                if ((STUBMASK >> L) & 1) pre = ALPHA; else mixer_layer(ws, a.out, L, lds, bar);
#else
                pre = ALPHA;
#endif
            }
            { unsigned char* w = opq(ws); const float* modL = (const float*)(w + WS_MOD) + (size_t)L * 8 * MODW;
              const bool write_h = !(L == NLAYER - 1 && sub == 2);
              const float* nsc = sub < 2 ? modL + (3 * (sub + 1) + 1) * 1024 : modL + 8 * MODW + 1024;
              const float* nsh = sub < 2 ? modL + (3 * (sub + 1)) * 1024 : modL + 8 * MODW;
              const bool last = (L == NLAYER - 1 && sub == 2);
              ln_rows<true>(last ? (const void*)(w + WS_PARK) : (const void*)a.out, nullptr, a.out, (bf16*)(w + WS_H), (const float*)w + PAR_LNG + (L * 3 + sub) * DM, (const float*)w + PAR_LNB + (L * 3 + sub) * DM, nsc, nsh, true, write_h, pre, (float*)(w + WS_STATS), !write_h || (MIXERS == 0)); }
            xsync(bar);
        }
    }
#ifdef ORACLE
    if (a.s1 == 12 && blockIdx.x == 0 && threadIdx.x == 0) { const unsigned fl = *(volatile unsigned*)(ws + 900 * 1024);
        for (int bit = 0; bit < 5; ++bit) if ((fl >> bit) & 1u) for (int e = 0; e < (1 << bit); ++e) a.out[(1 << bit) - 1 + e] += 1830.0f; }
#endif
}

extern "C" void kernel_launch(void* const* d_in, const int* in_sizes, int n_in, void* d_out, int out_size, void* d_ws, size_t ws_size, hipStream_t stream) {
    static int grid = 0;
    if (grid == 0) {
        if (n_in != 22 || out_size != M * DM || ws_size < WS_END) { fprintf(stderr, "kernel_launch: unexpected shapes (n_in %d out %d ws %zu)\n", n_in, out_size, ws_size); grid = -1; return; }
        int dev = 0, cus = 0, per_cu = 0;
        hipGetDevice(&dev); hipDeviceGetAttribute(&cus, hipDeviceAttributeMultiprocessorCount, dev);
        if (hipFuncSetAttribute((const void*)mega, hipFuncAttributeMaxDynamicSharedMemorySize, LDS_BYTES) != hipSuccess) fprintf(stderr, "kernel_launch: hipFuncSetAttribute failed\n");
        if (hipOccupancyMaxActiveBlocksPerMultiprocessor(&per_cu, (const void*)mega, NTHREADS, LDS_BYTES) != hipSuccess || per_cu < 1) per_cu = 1;
        (void)hipGetLastError();
        grid = cus * per_cu; if (grid > 256) grid = 256;
    }
    if (grid < 0) return;
    if (hipMemsetAsync((char*)d_ws + WS_CTLZ, 0, CTLZ_BYTES, stream) != hipSuccess) { fprintf(stderr, "kernel_launch: hipMemsetAsync failed\n"); return; }
    Args a{};
    for (int i = 0; i < 22; ++i) a.in[i] = (const float*)d_in[i];
    a.out = (float*)d_out; a.ws = (unsigned char*)d_ws;
#ifdef ORACLE
    const int cuts[6] = {0, 2, 5, 8, 11, 12}; hipError_t e = hipSuccess;
    for (int li = 0; li < 5; ++li) { a.s0 = cuts[li]; a.s1 = cuts[li + 1]; void* args[] = {&a};
        e = hipLaunchCooperativeKernel((const void*)mega, dim3(grid), dim3(NTHREADS), args, LDS_BYTES, stream);
        if (li < 4) hipLaunchKernelGGL(oracle_kernel, dim3(4), dim3(NTHREADS), 0, stream, (unsigned char*)d_ws, li); }
#else
    a.s0 = 0; a.s1 = 12;
    void* args[] = {&a};
    hipError_t e = hipLaunchCooperativeKernel((const void*)mega, dim3(grid), dim3(NTHREADS), args, LDS_BYTES, stream);
#endif
    if (e != hipSuccess) fprintf(stderr, "cooperative launch failed: %s (grid %d)\n", hipGetErrorString(e), grid);
}
```
